# Optimizing an MI355X kernel written in HIP

```python
import math
import jax, jax.numpy as jnp
from jax import lax
import numpy as np

D_MODEL = 1024
BATCH = 8
SEQ = 4096
DEPTH = 1

HEAD_DIM = 64
ATT_WIDTH = D_MODEL
CONV_WIDTH = D_MODEL
MIX_WIDTH = ATT_WIDTH + CONV_WIDTH
N_Q_HEADS = ATT_WIDTH // HEAD_DIM
N_KV_HEADS = 4
Q_PER_KV = N_Q_HEADS // N_KV_HEADS
KV_WIDTH = N_KV_HEADS * HEAD_DIM
N_CONV_GROUPS = CONV_WIDTH // HEAD_DIM
CONV_K = 31
DILATED_PATTERNS = ((128, 1), (512, 4), (2048, 16))
BLK = 128
NORM_EPS = 1e-6
LN_EPS = 1e-5
SPLIT_SIZES = (ATT_WIDTH, KV_WIDTH, KV_WIDTH, ATT_WIDTH, CONV_WIDTH, CONV_WIDTH, CONV_WIDTH)
IN_COLS = sum(SPLIT_SIZES)

kernel_name = "hybrid_dilated_attn_conformer_conv"


def rmsnorm(x, g):
    xf = x.astype(jnp.float32)
    y = xf * lax.rsqrt(jnp.mean(xf * xf, axis=-1, keepdims=True) + NORM_EPS)
    return (y * g.astype(jnp.float32)).astype(x.dtype)


def layernorm(x, g, b):
    xf = x.astype(jnp.float32)
    mu = jnp.mean(xf, axis=-1, keepdims=True)
    var = jnp.mean(jnp.square(xf - mu), axis=-1, keepdims=True)
    y = (xf - mu) * lax.rsqrt(var + LN_EPS)
    return (y * g.astype(jnp.float32) + b.astype(jnp.float32)).astype(x.dtype)


def alibi_slopes(n):
    return jnp.exp2(-8.0 * (jnp.arange(n, dtype=jnp.float32) + 1.0) / n)


def _to_blocks(t, dilation, n_blocks):
    b, s = t.shape[:2]
    rest = t.shape[2:]
    sub_len = s // dilation
    t = t.reshape((b, sub_len, dilation) + rest)
    t = jnp.moveaxis(t, 2, 1)
    t = jnp.pad(t, [(0, 0), (0, 0), (0, n_blocks * BLK - sub_len)] + [(0, 0)] * len(rest))
    return t.reshape((b, dilation, n_blocks, BLK) + rest)


def _from_blocks(t, seq):
    b, d, nb = t.shape[:3]
    rest = t.shape[4:]
    sub_len = seq // d
    t = t.reshape((b, d, nb * BLK) + rest)[:, :, :sub_len]
    t = jnp.moveaxis(t, 1, 2)
    return t.reshape((b, seq) + rest)


def _with_prev_block(t):
    prev = jnp.pad(t, [(0, 0), (0, 0), (1, 0)] + [(0, 0)] * (t.ndim - 3))[:, :, :-1]
    return jnp.concatenate([prev, t], axis=3)


def dilated_window_attention(q, k, v, slopes, window, dilation):
    seq = q.shape[1]
    sub_len = seq // dilation
    w = window // dilation
    nb = -(-sub_len // BLK)
    qb = _to_blocks(q, dilation, nb)
    kw = _with_prev_block(_to_blocks(k, dilation, nb))
    vw = _with_prev_block(_to_blocks(v, dilation, nb))
    s = jnp.einsum('brnqhgc,brnkhc->brnhgqk', qb, kw).astype(jnp.float32)
    qi = jnp.arange(BLK)[:, None]
    kj = jnp.arange(2 * BLK)[None, :]
    dist = BLK + qi - kj
    kpos = (jnp.arange(nb)[:, None, None] - 1) * BLK + kj
    valid = (dist >= 0) & (dist <= w) & (kpos >= 0)
    bias = -slopes[:, :, None, None] * (dist * dilation).astype(jnp.float32)
    s = jnp.where(valid[:, None, None], s + bias, -jnp.inf)
    m = jnp.max(s, axis=-1, keepdims=True)
    p = jnp.exp(s - m)
    l = jnp.sum(p, axis=-1)
    o = jnp.einsum('brnhgqk,brnkhc->brnqhgc', p, vw.astype(jnp.float32))
    l_q = jnp.moveaxis(l, -1, 3)
    o = o / l_q[..., None]
    lse = jnp.moveaxis(m[..., 0], -1, 3) + jnp.log(l_q)
    return _from_blocks(o, seq), _from_blocks(lse, seq)


def attention_branch(q, k, v, gate):
    b, s, _ = q.shape
    q = q.reshape(b, s, N_KV_HEADS, Q_PER_KV, HEAD_DIM) * (HEAD_DIM ** -0.5)
    k = k.reshape(b, s, N_KV_HEADS, HEAD_DIM)
    v = v.reshape(b, s, N_KV_HEADS, HEAD_DIM)
    slopes = alibi_slopes(N_Q_HEADS).reshape(N_KV_HEADS, Q_PER_KV)
    outs, lses = [], []
    for window, dilation in DILATED_PATTERNS:
        o, lse = dilated_window_attention(q, k, v, slopes, window, dilation)
        outs.append(o)
        lses.append(lse)
    wts = jax.nn.softmax(jnp.stack(lses, axis=0), axis=0)
    o = jnp.sum(wts[..., None] * jnp.stack(outs, axis=0), axis=0)
    o = o.reshape(b, s, ATT_WIDTH).astype(gate.dtype)
    return o * jax.nn.silu(gate)


def conv_branch(val, glu_gate, gate, conv_w, conv_b, ln_g, ln_b):
    h = val * jax.nn.sigmoid(glu_gate)
    h = lax.conv_general_dilated(
        h, conv_w.astype(h.dtype)[:, None, :], window_strides=(1,),
        padding=[(CONV_K - 1, 0)], dimension_numbers=('NWC', 'WIO', 'NWC'),
        feature_group_count=CONV_WIDTH) + conv_b.astype(h.dtype)
    h = layernorm(h, ln_g, ln_b)
    h = jax.nn.silu(h)
    return h * jax.nn.silu(gate)


def setup_inputs(seed: int = 0) -> dict:
    key = jax.random.key(seed)
    ks = jax.random.split(key, 9)
    f32 = jnp.float32
    x = jax.random.normal(ks[0], (BATCH, SEQ, D_MODEL), f32)
    norm_g = 1.0 + 0.02 * jax.random.normal(ks[1], (DEPTH, D_MODEL), f32)
    w_in = jax.random.normal(ks[2], (DEPTH, D_MODEL, IN_COLS), f32) * D_MODEL ** -0.5
    conv_w = jax.random.normal(ks[3], (DEPTH, CONV_K, CONV_WIDTH), f32) * CONV_K ** -0.5
    conv_b = 0.02 * jax.random.normal(ks[4], (DEPTH, CONV_WIDTH), f32)
    conv_ln_g = 1.0 + 0.02 * jax.random.normal(ks[5], (DEPTH, CONV_WIDTH), f32)
    conv_ln_b = 0.02 * jax.random.normal(ks[6], (DEPTH, CONV_WIDTH), f32)
    w_out = jax.random.normal(ks[7], (DEPTH, MIX_WIDTH, D_MODEL), f32) * MIX_WIDTH ** -0.5
    final_norm_g = 1.0 + 0.02 * jax.random.normal(ks[8], (D_MODEL,), f32)
    return {"x": x, "norm_g": norm_g, "w_in": w_in, "conv_w": conv_w, "conv_b": conv_b,
            "conv_ln_g": conv_ln_g, "conv_ln_b": conv_ln_b, "w_out": w_out,
            "final_norm_g": final_norm_g}


def reference(x, norm_g, w_in, conv_w, conv_b, conv_ln_g, conv_ln_b, w_out, final_norm_g):
    split_idx = list(np.cumsum(SPLIT_SIZES)[:-1])
    for layer in range(DEPTH):
        h = rmsnorm(x, norm_g[layer])
        proj = jnp.einsum('bsd,de->bse', h, w_in[layer])
        q, k, v, a_gate, c_val, c_glu, c_gate = jnp.split(proj, split_idx, axis=-1)
        y_att = attention_branch(q, k, v, a_gate)
        y_conv = conv_branch(c_val, c_glu, c_gate, conv_w[layer], conv_b[layer],
                             conv_ln_g[layer], conv_ln_b[layer])
        y = jnp.concatenate([y_att, y_conv], axis=-1)
        x = x + jnp.einsum('bse,ed->bsd', y, w_out[layer])
    return rmsnorm(x, final_norm_g)
```

```cpp
#include <hip/hip_runtime.h>
#include <hip/hip_cooperative_groups.h>
#include <cstdio>
#include <cstdint>
namespace cg = cooperative_groups;
namespace pg8 {
#define PG8_LAS __attribute__((address_space(3)))
typedef unsigned short bf16_t;
typedef short bf16x8 __attribute__((ext_vector_type(8)));
typedef float f32x4 __attribute__((ext_vector_type(4)));
typedef unsigned u32x4 __attribute__((ext_vector_type(4)));
constexpr int BM = 256, BK = 64, HALF = 128, HTB = HALF * BK * 2  , STAGE_BYTES = 8 * HTB, NXCD = 8, WGM = 8;

__host__ __device__ __forceinline__ int lds_byte(int r, int c) { const int st = (r >> 4) * 2 + (c >> 5), rr = r & 15, cc = c & 31, ob = rr * 64 + cc * 2; return st * 1024 + (ob ^ (((ob >> 9) & 1) << 5)); }
__host__ __device__ __forceinline__ void stage_rc(int b, int& R, int& C) { const int st = b / 1024, sb = b % 1024, swz = sb ^ (((sb >> 9) & 1) << 5); R = (st >> 1) * 16 + swz / 64; C = (st & 1) * 32 + (swz % 64) / 2; }
__host__ __device__ __forceinline__ int perm32(int rho) { const int n = rho >> 4, i = rho & 15; return 8 * (i >> 2) + 4 * n + (i & 3); }

struct Unit { int pm, pn; };
struct Gemm { const bf16_t* A; const bf16_t* Bt; int M, N, K; };

struct StaticOrder {
    int nM, nN, nwg, G, c;
    __host__ __device__ void init(int M, int N, int G_, int c_) { nM = M / BM; nN = N / BM; nwg = nM * nN; G = G_; c = c_; }
    __host__ __device__ bool next(int i, Unit& u) const {
        const long L = (long)i * G + c; if (L >= nwg) return false;
        int wgid = (int)L; { const int q = nwg / NXCD, r = nwg % NXCD, xcd = wgid % NXCD, off = wgid / NXCD; wgid = (xcd < r ? xcd * (q + 1) : r * (q + 1) + (xcd - r) * q) + off; }
        const int nig = WGM * nN, gid = wgid / nig, fm = gid * WGM, gsz = (nM - fm) < WGM ? (nM - fm) : WGM;
        u.pm = fm + ((wgid % nig) % gsz); u.pn = (wgid % nig) / gsz; return true;
    }
    __device__ __forceinline__ void a_ready(const Unit&) const {}
    __device__ __forceinline__ void done(const Unit&) const {}
};
__device__ __forceinline__ unsigned cvt_pk_bf16(float lo, float hi) { unsigned r; asm volatile("v_cvt_pk_bf16_f32 %0, %1, %2" : "=v"(r) : "v"(lo), "v"(hi)); return r; }
typedef float f32x2 __attribute__((ext_vector_type(2)));
template <class Epi, class Sched, bool STAMP = false>
__device__ __forceinline__ void gemm_phase(PG8_LAS unsigned char* lds, const Gemm g, const Sched& S, const Epi& E, unsigned long long* stamps) {
    const int tid = threadIdx.x, wid = __builtin_amdgcn_readfirstlane(tid >> 6), lane = tid & 63, wr = wid >> 2, wc = wid & 3, fr = lane & 15, fq = lane >> 4;
    const int K = g.K, nt = K / BK;
    int ts_lo = 0, ts_hi = 0, nts = 0; const unsigned long long rt_entry = STAMP ? (unsigned long long)wall_clock64() : 0ull;
#define PG8_STAMP() do { if (STAMP && wid == 0 && nts < 64) { const unsigned long long _c = (unsigned long long)clock64(); \
        ts_lo = (lane == nts) ? (int)(unsigned)_c : ts_lo; ts_hi = (lane == nts) ? (int)(unsigned)(_c >> 32) : ts_hi; ++nts; } } while (0)
    PG8_STAMP();
    unsigned voffA[2], voffB[2];
#pragma unroll
    for (int i = 0; i < 2; ++i) { int R, C; stage_rc(tid * 16 + i * 8192, R, C); const int Rb = Epi::PERM ? ((R & ~31) + perm32(R & 31)) : R;
        voffA[i] = (unsigned)(R * K + C) * 2u; voffB[i] = (unsigned)(Rb * K + C) * 2u; }
    const size_t kstep = (size_t)(BK * 2);
    const size_t hstep = (size_t)HALF * K * 2;
    const size_t tstep = 2 * hstep;
    const unsigned ldsw = (unsigned)wid * 1024u;
    const int aoff = lds_byte(wr * 64 + fr, fq * 8), boff = lds_byte(wc * 32 + fr, fq * 8);
#define PG8_SA(b, h) (((b) * 2 + (h)) * HTB)
#define PG8_SB(b, h) ((4 + (b) * 2 + (h)) * HTB)
#define PG8_STAGE(bufoff, gbase, voff) do { _Pragma("unroll") for (int _i = 0; _i < 2; ++_i) \
        __builtin_amdgcn_global_load_lds((const unsigned*)((const char*)(gbase) + (voff)[_i]), (PG8_LAS unsigned*)(lds + (bufoff) + ldsw + _i * 8192), 16, 0, 0); } while (0)
#define PG8_LDA(dst, b, h) do { _Pragma("unroll") for (int m = 0; m < 4; ++m) _Pragma("unroll") for (int k = 0; k < 2; ++k) dst[m][k] = *(const PG8_LAS bf16x8*)(lds + PG8_SA(b, h) + aoff + m * 2048 + k * 1024); } while (0)
#define PG8_LDB(dst, b, h) do { _Pragma("unroll") for (int n = 0; n < 2; ++n) _Pragma("unroll") for (int k = 0; k < 2; ++k) dst[n][k] = *(const PG8_LAS bf16x8*)(lds + PG8_SB(b, h) + boff + n * 2048 + k * 1024); } while (0)
#define PG8_MMA(ai, bj, At, Bt) do { __builtin_amdgcn_s_setprio(1); _Pragma("unroll") for (int m = 0; m < 4; ++m) _Pragma("unroll") for (int n = 0; n < 2; ++n) _Pragma("unroll") for (int k = 0; k < 2; ++k) \
        acc[ai][bj][m][n] = __builtin_amdgcn_mfma_f32_16x16x32_bf16(Bt[n][k], At[m][k], acc[ai][bj][m][n], 0, 0, 0); __builtin_amdgcn_s_setprio(0); } while (0)
#define PG8_WAIT_V(n) asm volatile("s_waitcnt vmcnt(" #n ")" ::: "memory")
#define PG8_WAIT_L(n) asm volatile("s_waitcnt lgkmcnt(" #n ")" ::: "memory")
#define PG8_BAR __builtin_amdgcn_s_barrier()
#define PG8_SCHED __builtin_amdgcn_sched_barrier(0)
    Unit cur, nxt; int ui = 0;
    if (!S.next(0, cur)) return;
    f32x4 acc[2][2][4][2];
#pragma unroll
    for (int a = 0; a < 2; ++a)
#pragma unroll
        for (int b = 0; b < 2; ++b)
#pragma unroll
            for (int m = 0; m < 4; ++m)
#pragma unroll
                for (int n = 0; n < 2; ++n) acc[a][b][m][n] = (f32x4){0.f, 0.f, 0.f, 0.f};
    bf16x8 At[4][2], B0[2][2], B1[2][2];
    const char* cA = (const char*)g.A + (size_t)cur.pm * tstep; const char* cB = (const char*)g.Bt + (size_t)cur.pn * tstep;
    S.a_ready(cur);
    PG8_STAGE(PG8_SB(0, 0), cB, voffB); PG8_STAGE(PG8_SA(0, 0), cA, voffA); PG8_STAGE(PG8_SB(0, 1), cB + hstep, voffB); PG8_STAGE(PG8_SA(0, 1), cA + hstep, voffA);
    if (wr == 1) PG8_BAR;
    PG8_WAIT_V(4); PG8_BAR;
    PG8_STAGE(PG8_SB(1, 0), cB + kstep, voffB); PG8_STAGE(PG8_SA(1, 0), cA + kstep, voffA); PG8_STAGE(PG8_SB(1, 1), cB + hstep + kstep, voffB);
    PG8_WAIT_V(6); PG8_BAR;
    PG8_STAMP();
    for (;;) {
        const bool has_next = S.next(ui + 1, nxt);
        const char* nA = has_next ? (const char*)g.A + (size_t)nxt.pm * tstep : cA; const char* nB = has_next ? (const char*)g.Bt + (size_t)nxt.pn * tstep : cB;
        for (int t = 0; t < nt; t += 2) {
            const bool last = (t == nt - 2);
            const char* a1 = cA + (size_t)(t + 1) * kstep;
            const char* a2 = last ? nA : cA + (size_t)(t + 2) * kstep; const char* b2 = last ? nB : cB + (size_t)(t + 2) * kstep;
            const char* a3 = a2 + kstep; const char* b3 = b2 + kstep;
            if (last && has_next) S.a_ready(nxt);
            PG8_LDB(B0, 0, 0); PG8_SCHED; PG8_LDA(At, 0, 0); PG8_STAGE(PG8_SA(1, 1), a1 + hstep, voffA);
            PG8_WAIT_L(8); PG8_BAR; PG8_WAIT_L(0); PG8_MMA(0, 0, At, B0); PG8_BAR; PG8_SCHED;
            PG8_LDB(B1, 0, 1); PG8_STAGE(PG8_SB(0, 0), b2, voffB);
            PG8_BAR; PG8_WAIT_L(0); PG8_MMA(0, 1, At, B1); PG8_BAR;
            PG8_LDA(At, 0, 1); PG8_STAGE(PG8_SA(0, 0), a2, voffA);
            PG8_BAR; PG8_WAIT_L(0); PG8_MMA(1, 0, At, B0); PG8_BAR; PG8_SCHED;
            PG8_STAGE(PG8_SB(0, 1), b2 + hstep, voffB);
            PG8_WAIT_V(6); PG8_BAR; PG8_MMA(1, 1, At, B1); PG8_BAR;
            PG8_LDB(B0, 1, 0); PG8_SCHED; PG8_LDA(At, 1, 0); PG8_STAGE(PG8_SA(0, 1), a2 + hstep, voffA);
            PG8_WAIT_L(8); PG8_BAR; PG8_WAIT_L(0); PG8_MMA(0, 0, At, B0); PG8_BAR; PG8_SCHED;
            PG8_LDB(B1, 1, 1); PG8_STAGE(PG8_SB(1, 0), b3, voffB);
            PG8_BAR; PG8_WAIT_L(0); PG8_MMA(0, 1, At, B1); PG8_BAR;
            PG8_LDA(At, 1, 1); PG8_STAGE(PG8_SA(1, 0), a3, voffA);
            PG8_BAR; PG8_WAIT_L(0); PG8_MMA(1, 0, At, B0); PG8_BAR; PG8_SCHED;
            PG8_STAGE(PG8_SB(1, 1), b3 + hstep, voffB);
            PG8_WAIT_V(6); PG8_BAR; PG8_MMA(1, 1, At, B1); PG8_BAR;
        }
        PG8_STAMP();
        if constexpr (!Epi::AFTER_DRAIN) { E(acc, cur, wr, wc, fr, fq); S.done(cur); }
        PG8_STAMP();
        if (!has_next) break;
#pragma unroll
        for (int a = 0; a < 2; ++a)
#pragma unroll
            for (int b = 0; b < 2; ++b)
#pragma unroll
                for (int m = 0; m < 4; ++m)
#pragma unroll
                    for (int n = 0; n < 2; ++n) acc[a][b][m][n] = (f32x4){0.f, 0.f, 0.f, 0.f};
        cur = nxt; cA = nA; cB = nB; ++ui;
    }
    PG8_WAIT_V(0);
    if (wr == 0) PG8_BAR;
    PG8_BAR;
    if constexpr (Epi::AFTER_DRAIN) { E.fused(acc, cur, wr, wc, fr, fq, lds, wid, lane); S.done(cur); }
    PG8_STAMP();
    if (STAMP && wid == 0) { stamps[lane] = lane < nts ? (((unsigned long long)(unsigned)ts_hi << 32) | (unsigned)ts_lo) : 0ull;
        if (lane == 62) stamps[62] = rt_entry; if (lane == 63) stamps[63] = (unsigned long long)wall_clock64(); }
#undef PG8_STAMP
#undef PG8_SA
#undef PG8_SB
#undef PG8_STAGE
#undef PG8_LDA
#undef PG8_LDB
#undef PG8_MMA
#undef PG8_WAIT_V
#undef PG8_WAIT_L
#undef PG8_BAR
#undef PG8_SCHED
}
}
using pg8::bf16_t; using pg8::bf16x8; using pg8::f32x4; using pg8::u32x4;
typedef float f32x16 __attribute__((ext_vector_type(16)));
typedef short s16x4 __attribute__((ext_vector_type(4)));
typedef float f32x2v __attribute__((ext_vector_type(2)));
typedef unsigned u32x2 __attribute__((ext_vector_type(2)));
typedef __bf16 bf2_t __attribute__((ext_vector_type(2)));
#define LAS __attribute__((address_space(3)))
#define DI __device__ __forceinline__

constexpr int BATCH = 8, SEQ = 4096, DM = 1024, NTOK = BATCH * SEQ, INC = 5632, MIXW = 2048;
constexpr int COL_K = 1024, COL_V = 1280, COL_AG = 1536, COL_CV = 2560, COL_CG = 3584, COL_CGATE = 4608;
constexpr float LOG2E = 1.4426950408889634f;
constexpr float QSCALE = 0.125f * LOG2E;
constexpr int LDS_BYTES = 131072;

struct Params {
    const float* x; const float* norm_g; const float* w_in; const float* conv_w; const float* conv_b; const float* ln_g; const float* ln_b; const float* w_out; const float* fin_g;
    float* out; bf16_t* H; bf16_t* WinT; bf16_t* WoutT; bf16_t* PROJ; bf16_t* Y; float* rowss;
};

DI float fexp2(float x) { return __builtin_amdgcn_exp2f(x); }
DI float frcp(float x) { return __builtin_amdgcn_rcpf(x); }
DI float sigm(float x) { return frcp(1.0f + fexp2(-x * LOG2E)); }
DI float silu(float x) { return x * sigm(x); }
DI unsigned pk_bf16(float a, float b) { f32x2v v = {a, b}; bf2_t r = __builtin_convertvector(v, bf2_t); return __builtin_bit_cast(unsigned, r); }
DI float bf_lo(unsigned w) { return __uint_as_float(w << 16); }
DI float bf_hi(unsigned w) { return __uint_as_float(w & 0xffff0000u); }
DI float wave_sum(float v) { for (int o = 32; o >= 1; o >>= 1) v += __shfl_xor(v, o); return v; }

struct EpiProj {
    static constexpr bool PERM = true, AFTER_DRAIN = false;
    bf16_t* O;
    __device__ __forceinline__ void operator()(const f32x4 (&acc)[2][2][4][2], const pg8::Unit& u, int wr, int wc, int fr, int fq) const {
        const int row0 = u.pm * 256 + wr * 64 + fr, col0 = u.pn * 256 + wc * 32 + 8 * fq, pn = u.pn;
        const int mode = pn < 4 ? 1 : pn < 6 ? 0 : pn < 10 ? 2 : pn < 14 ? 0 : pn < 18 ? 3 : 2;
#pragma unroll
        for (int ai = 0; ai < 2; ++ai)
#pragma unroll
            for (int m = 0; m < 4; ++m) { bf16_t* rowp = O + (size_t)(row0 + ai * 128 + m * 16) * INC + col0;
#pragma unroll
                for (int bj = 0; bj < 2; ++bj) { float v[8];
#pragma unroll
                    for (int j = 0; j < 4; ++j) { v[j] = acc[ai][bj][m][0][j]; v[4 + j] = acc[ai][bj][m][1][j]; }
                    if (mode == 1) {
#pragma unroll
                        for (int j = 0; j < 8; ++j) v[j] *= QSCALE;
                    } else if (mode == 2) {
#pragma unroll
                        for (int j = 0; j < 8; ++j) v[j] = silu(v[j]);
                    } else if (mode == 3) {
#pragma unroll
                        for (int j = 0; j < 8; ++j) v[j] = sigm(v[j]);
                    }
                    u32x4 w; w.x = pk_bf16(v[0], v[1]); w.y = pk_bf16(v[2], v[3]); w.z = pk_bf16(v[4], v[5]); w.w = pk_bf16(v[6], v[7]);
                    *(u32x4*)(rowp + bj * 128) = w; } }
    }
};
struct EpiOut {
    static constexpr bool PERM = false, AFTER_DRAIN = false;
    const float* X; float* out; float* rowss;
    __device__ __forceinline__ void operator()(const f32x4 (&acc)[2][2][4][2], const pg8::Unit& u, int wr, int wc, int fr, int fq) const {
        const int row0 = u.pm * 256 + wr * 64 + fr, col0 = u.pn * 256 + wc * 32 + 4 * fq;
#pragma unroll
        for (int ai = 0; ai < 2; ++ai)
#pragma unroll
            for (int m = 0; m < 4; ++m) { const int r = row0 + ai * 128 + m * 16; const size_t off = (size_t)r * DM + col0; float ss = 0.f;
#pragma unroll
                for (int bj = 0; bj < 2; ++bj)
#pragma unroll
                    for (int n = 0; n < 2; ++n) { const f32x4 xv = *(const f32x4*)(X + off + bj * 128 + n * 16); const f32x4 z = xv + acc[ai][bj][m][n];
                        *(f32x4*)(out + off + bj * 128 + n * 16) = z; ss += (z[0] * z[0] + z[1] * z[1]) + (z[2] * z[2] + z[3] * z[3]); }
                ss += __shfl_xor(ss, 16); ss += __shfl_xor(ss, 32);
                if (fq == 0) rowss[(size_t)r * 16 + u.pn * 4 + wc] = ss;
                asm volatile("" ::: "memory"); }
    }
};

DI void prep_phase(const Params& p, LAS unsigned char* lds) {
    const int tid = threadIdx.x, wid = tid >> 6, lane = tid & 63;
    for (int row = blockIdx.x * 8 + wid; row < NTOK; row += gridDim.x * 8) {
        const float* xr = p.x + (size_t)row * DM;
        f32x4 v[4]; float ss = 0.f;
#pragma unroll
        for (int j = 0; j < 2; ++j) { v[2 * j] = *(const f32x4*)(xr + j * 512 + lane * 8); v[2 * j + 1] = *(const f32x4*)(xr + j * 512 + lane * 8 + 4); }
#pragma unroll
        for (int j = 0; j < 4; ++j) ss += (v[j][0] * v[j][0] + v[j][1] * v[j][1]) + (v[j][2] * v[j][2] + v[j][3] * v[j][3]);
        ss = wave_sum(ss);
        const float rstd = rsqrtf(ss * (1.0f / DM) + 1e-6f);
#pragma unroll
        for (int j = 0; j < 2; ++j) { const f32x4 g0 = *(const f32x4*)(p.norm_g + j * 512 + lane * 8), g1 = *(const f32x4*)(p.norm_g + j * 512 + lane * 8 + 4);
            const f32x4 a = v[2 * j] * rstd * g0, b = v[2 * j + 1] * rstd * g1;
            u32x4 w; w.x = pk_bf16(a[0], a[1]); w.y = pk_bf16(a[2], a[3]); w.z = pk_bf16(b[0], b[1]); w.w = pk_bf16(b[2], b[3]);
            *(u32x4*)(p.H + (size_t)row * DM + j * 512 + lane * 8) = w; }
    }
    LAS float* tile = (LAS float*)lds;
    for (int t = blockIdx.x; t < 1408 + 512; t += gridDim.x) {
        const float* src; bf16_t* dst; int ldS, ldD;
        if (t < 1408) { const int kt = t / 88, nt = t % 88; src = p.w_in + (size_t)kt * 64 * INC + nt * 64; ldS = INC; dst = p.WinT + (size_t)nt * 64 * DM + kt * 64; ldD = DM; }
        else { const int t2 = t - 1408, kt = t2 / 16, nt = t2 % 16; src = p.w_out + (size_t)kt * 64 * DM + nt * 64; ldS = DM; dst = p.WoutT + (size_t)nt * 64 * MIXW + kt * 64; ldD = MIXW; }
#pragma unroll
        for (int e = 0; e < 8; ++e) { const int idx = tid + 512 * e, k = idx >> 6, n = idx & 63; tile[k * 65 + n] = src[(size_t)k * ldS + n]; }
        __syncthreads();
        { const int n = tid >> 3, kc = (tid & 7) * 8; float f[8];
#pragma unroll
          for (int j = 0; j < 8; ++j) f[j] = tile[(kc + j) * 65 + n];
          u32x4 w; w.x = pk_bf16(f[0], f[1]); w.y = pk_bf16(f[2], f[3]); w.z = pk_bf16(f[4], f[5]); w.w = pk_bf16(f[6], f[7]);
          *(u32x4*)(dst + (size_t)n * ldD + kc) = w; }
        __syncthreads();
    }
}

struct ATile { bf16x8 k[4]; u32x4 v[4]; };
DI void attn_issue(const bf16_t* projb, int kvh, int utop, int tix, int n, int h, int lane, ATile& T) {
    const int d = tix < 8 ? 1 : tix < 13 ? 4 : 16, tau = tix < 8 ? tix : tix < 13 ? tix - 8 : tix - 13;
    int uk = utop - d * (32 * tau + n); uk = uk < 0 ? 0 : uk;
    const bf16_t* kp = projb + (size_t)uk * INC + COL_K + kvh * 64 + 8 * h;
#pragma unroll
    for (int s = 0; s < 4; ++s) T.k[s] = *(const bf16x8*)(kp + 16 * s);
#pragma unroll
    for (int jj = 0; jj < 4; ++jj) { const int row = 8 * jj + (lane >> 3); int uv = utop - d * (32 * tau + row); uv = uv < 0 ? 0 : uv;
        T.v[jj] = *(const u32x4*)(projb + (size_t)uv * INC + COL_V + kvh * 64 + (lane & 7) * 8); }
}
DI void attn_phase(const Params& p, LAS unsigned char* lds) {
    const int tid = threadIdx.x, wid = tid >> 6, lane = tid & 63, n = lane & 31, h = lane >> 5, g = n >> 3, iq = n & 7;
    LAS unsigned char* vbuf = lds + wid * 4096;
    const unsigned vb = (unsigned)(uintptr_t)vbuf;
    unsigned ta0, ta1;
    { const int i16 = lane & 15, q = i16 >> 2, pp = i16 & 3, blk = (lane >> 4) & 1, sw = (q >> 1) & 1;
      const unsigned rowoff = (unsigned)(4 * h + q) * 128u + 8u * (pp & 1);
      ta0 = vb + rowoff + (unsigned)(((2 * blk + (pp >> 1)) ^ (sw << 2)) * 16);
      ta1 = vb + rowoff + (unsigned)(((4 + 2 * blk + (pp >> 1)) ^ (sw << 2)) * 16); }
    for (int gidx = blockIdx.x; gidx < 1024; gidx += gridDim.x) {
        const int xx = gidx & 7, cj = (gidx >> 3) & 31, it = gidx >> 8, pair = xx + 8 * it, b = pair >> 2, kvh = pair & 3, T0 = cj * 128;
        const bf16_t* projb = p.PROJ + (size_t)b * SEQ * INC;
        for (int rr = 0; rr < 2; ++rr) {
            const int r = wid + 8 * rr, tq = T0 + r + 16 * iq, utop = T0 + r + 112, head = kvh * 4 + g;
            const float slope2 = fexp2(-0.5f * (float)(head + 1)) * LOG2E;
            bf16x8 qf[4];
            { const bf16_t* qp = projb + (size_t)tq * INC + head * 64 + 8 * h;
#pragma unroll
              for (int s = 0; s < 4; ++s) qf[s] = *(const bf16x8*)(qp + 16 * s); }
            f32x16 o0, o1;
#pragma unroll
            for (int i = 0; i < 16; ++i) { o0[i] = 0.f; o1[i] = 0.f; }
            float mrow = -1e30f, lrow = 0.f;
            ATile cur; attn_issue(projb, kvh, utop, 0, n, h, lane, cur);
            for (int tix = 0; tix < 18; ++tix) {
                ATile nxt; attn_issue(projb, kvh, utop, tix < 17 ? tix + 1 : 17, n, h, lane, nxt);
                const int d = tix < 8 ? 1 : tix < 13 ? 4 : 16, tau = tix < 8 ? tix : tix < 13 ? tix - 8 : tix - 13;
#pragma unroll
                for (int jj = 0; jj < 4; ++jj) { const int row = 8 * jj + (lane >> 3), ch = lane & 7;
                    *(LAS u32x4*)(vbuf + row * 128 + ((ch ^ (((row >> 1) & 1) << 2)) * 16)) = cur.v[jj]; }
                f32x16 sa;
#pragma unroll
                for (int i = 0; i < 16; ++i) sa[i] = 0.f;
#pragma unroll
                for (int s = 0; s < 4; ++s) sa = __builtin_amdgcn_mfma_f32_32x32x16_bf16(cur.k[s], qf[s], sa, 0, 0, 0);
                const float dbf = (float)((tq - utop) + d * 32 * tau), df = (float)d;
                const int limi = 128 * d < tq ? 128 * d : tq; const float limf = (float)limi;
                float sv[16]; float rmax = -__builtin_inff();
#pragma unroll
                for (int i = 0; i < 16; ++i) { const float kk = (float)((i & 3) + 8 * (i >> 2) + 4 * h); const float dist = dbf + df * kk;
                    const bool valid = (dist >= 0.f) && (dist <= limf);
                    const float sc = valid ? (sa[i] - slope2 * dist) : -__builtin_inff(); sv[i] = sc; rmax = fmaxf(rmax, sc); }
                rmax = fmaxf(rmax, __shfl_xor(rmax, 32));
                const float mnew = fmaxf(mrow, rmax), alpha = fexp2(mrow - mnew);
                float rs = 0.f;
#pragma unroll
                for (int i = 0; i < 16; ++i) { sv[i] = fexp2(sv[i] - mnew); rs += sv[i]; }
                rs += __shfl_xor(rs, 32);
                lrow = lrow * alpha + rs; mrow = mnew;
#pragma unroll
                for (int i = 0; i < 16; ++i) { o0[i] *= alpha; o1[i] *= alpha; }
                u32x4 pw0, pw1;
                pw0.x = pk_bf16(sv[0], sv[1]); pw0.y = pk_bf16(sv[2], sv[3]); pw0.z = pk_bf16(sv[4], sv[5]); pw0.w = pk_bf16(sv[6], sv[7]);
                pw1.x = pk_bf16(sv[8], sv[9]); pw1.y = pk_bf16(sv[10], sv[11]); pw1.z = pk_bf16(sv[12], sv[13]); pw1.w = pk_bf16(sv[14], sv[15]);
                const bf16x8 pf0 = __builtin_bit_cast(bf16x8, pw0), pf1 = __builtin_bit_cast(bf16x8, pw1);
                s16x4 t0, t1, t2, t3, t4, t5, t6, t7;
                asm volatile("s_waitcnt lgkmcnt(0)\n\t"
                             "ds_read_b64_tr_b16 %0, %8\n\t"
                             "ds_read_b64_tr_b16 %1, %8 offset:1024\n\t"
                             "ds_read_b64_tr_b16 %2, %8 offset:2048\n\t"
                             "ds_read_b64_tr_b16 %3, %8 offset:3072\n\t"
                             "ds_read_b64_tr_b16 %4, %9\n\t"
                             "ds_read_b64_tr_b16 %5, %9 offset:1024\n\t"
                             "ds_read_b64_tr_b16 %6, %9 offset:2048\n\t"
                             "ds_read_b64_tr_b16 %7, %9 offset:3072\n\t"
                             "s_waitcnt lgkmcnt(0)"
                             : "=&v"(t0), "=&v"(t1), "=&v"(t2), "=&v"(t3), "=&v"(t4), "=&v"(t5), "=&v"(t6), "=&v"(t7) : "v"(ta0), "v"(ta1) : "memory");
                const bf16x8 v00 = __builtin_shufflevector(t0, t1, 0, 1, 2, 3, 4, 5, 6, 7), v01 = __builtin_shufflevector(t2, t3, 0, 1, 2, 3, 4, 5, 6, 7);
                const bf16x8 v10 = __builtin_shufflevector(t4, t5, 0, 1, 2, 3, 4, 5, 6, 7), v11 = __builtin_shufflevector(t6, t7, 0, 1, 2, 3, 4, 5, 6, 7);
                o0 = __builtin_amdgcn_mfma_f32_32x32x16_bf16(v00, pf0, o0, 0, 0, 0);
                o0 = __builtin_amdgcn_mfma_f32_32x32x16_bf16(v01, pf1, o0, 0, 0, 0);
                o1 = __builtin_amdgcn_mfma_f32_32x32x16_bf16(v10, pf0, o1, 0, 0, 0);
                o1 = __builtin_amdgcn_mfma_f32_32x32x16_bf16(v11, pf1, o1, 0, 0, 0);
                cur = nxt;
            }
            const float inv = 1.0f / lrow;
            const bf16_t* gp = projb + (size_t)tq * INC + COL_AG + head * 64 + 4 * h;
            bf16_t* yp = p.Y + ((size_t)b * SEQ + tq) * MIXW + head * 64 + 4 * h;
#pragma unroll
            for (int ct = 0; ct < 2; ++ct)
#pragma unroll
                for (int gq = 0; gq < 4; ++gq) { const u32x2 gw = *(const u32x2*)(gp + 32 * ct + 8 * gq);
                    const float a0 = (ct ? o1[4 * gq] : o0[4 * gq]) * inv * bf_lo(gw.x), a1 = (ct ? o1[4 * gq + 1] : o0[4 * gq + 1]) * inv * bf_hi(gw.x);
                    const float a2 = (ct ? o1[4 * gq + 2] : o0[4 * gq + 2]) * inv * bf_lo(gw.y), a3 = (ct ? o1[4 * gq + 3] : o0[4 * gq + 3]) * inv * bf_hi(gw.y);
                    u32x2 ow; ow.x = pk_bf16(a0, a1); ow.y = pk_bf16(a2, a3);
                    *(u32x2*)(yp + 32 * ct + 8 * gq) = ow; }
        }
    }
}

#define CONV_BFLY(V, N, MASK) { _Pragma("unroll") for (int i_ = 0; i_ < (N); ++i_) { const bool up_ = (lane & (MASK)) != 0; const float keep_ = up_ ? V[i_ + (N)] : V[i_]; const float send_ = up_ ? V[i_] : V[i_ + (N)]; V[i_] = keep_ + __shfl_xor(send_, (MASK)); } }
DI void conv_phase(const Params& p, LAS unsigned char* lds) {
    const int tid = threadIdx.x, wid = tid >> 6, lane = tid & 63, ch = tid * 2;
    f32x2v w[31];
#pragma unroll
    for (int k = 0; k < 31; ++k) w[k] = *(const f32x2v*)(p.conv_w + k * DM + ch);
    const f32x2v cb = *(const f32x2v*)(p.conv_b + ch), lg = *(const f32x2v*)(p.ln_g + ch), lb = *(const f32x2v*)(p.ln_b + ch);
    LAS float* part = (LAS float*)lds;
    LAS float* stats = part + 512;
    for (int tile = blockIdx.x; tile < NTOK / 32; tile += gridDim.x) {
        const int tok0 = tile * 32, b = tok0 / SEQ, s0 = tok0 % SEQ;
        const bf16_t* projb = p.PROJ + (size_t)b * SEQ * INC;
        f32x2v acc[32];
#pragma unroll
        for (int t = 0; t < 32; ++t) acc[t] = cb;
#pragma clang loop unroll(full)
        for (int js = 0; js < 62; ++js) {
            const int s = s0 - 30 + js;
            f32x2v xin = {0.f, 0.f};
            if (s >= 0) { const bf16_t* pr = projb + (size_t)s * INC + ch; const unsigned vv = *(const unsigned*)(pr + COL_CV), gg = *(const unsigned*)(pr + COL_CG);
                xin[0] = bf_lo(vv) * bf_lo(gg); xin[1] = bf_hi(vv) * bf_hi(gg); }
#pragma clang loop unroll(full)
            for (int t = 0; t < 32; ++t) { const int k = js - t; if (k >= 0 && k <= 30) acc[t] += w[k] * xin; }
        }
        float v1[32], v2[32];
#pragma unroll
        for (int t = 0; t < 32; ++t) { v1[t] = acc[t][0] + acc[t][1]; v2[t] = acc[t][0] * acc[t][0] + acc[t][1] * acc[t][1]; }
        CONV_BFLY(v1, 16, 32) CONV_BFLY(v1, 8, 16) CONV_BFLY(v1, 4, 8) CONV_BFLY(v1, 2, 4) CONV_BFLY(v1, 1, 2)
        CONV_BFLY(v2, 16, 32) CONV_BFLY(v2, 8, 16) CONV_BFLY(v2, 4, 8) CONV_BFLY(v2, 2, 4) CONV_BFLY(v2, 1, 2)
        v1[0] += __shfl_xor(v1[0], 1); v2[0] += __shfl_xor(v2[0], 1);
        if ((lane & 1) == 0) { part[(wid * 32 + (lane >> 1)) * 2] = v1[0]; part[(wid * 32 + (lane >> 1)) * 2 + 1] = v2[0]; }
        __syncthreads();
        if (tid < 32) { float a = 0.f, q = 0.f;
#pragma unroll
            for (int wv = 0; wv < 8; ++wv) { a += part[(wv * 32 + tid) * 2]; q += part[(wv * 32 + tid) * 2 + 1]; }
            const float mean = a * (1.0f / DM), var = q * (1.0f / DM) - mean * mean;
            stats[tid * 2] = mean; stats[tid * 2 + 1] = rsqrtf(fmaxf(var, 0.f) + 1e-5f); }
        __syncthreads();
#pragma unroll
        for (int t = 0; t < 32; ++t) { const float mean = stats[t * 2], rstd = stats[t * 2 + 1];
            const unsigned gw = *(const unsigned*)(projb + (size_t)(s0 + t) * INC + COL_CGATE + ch);
            const float y0 = silu((acc[t][0] - mean) * rstd * lg[0] + lb[0]) * bf_lo(gw), y1 = silu((acc[t][1] - mean) * rstd * lg[1] + lb[1]) * bf_hi(gw);
            *(unsigned*)(p.Y + ((size_t)tok0 + t) * MIXW + DM + ch) = pk_bf16(y0, y1); }
    }
}

DI void final_phase(const Params& p) {
    const int tid = threadIdx.x, wid = tid >> 6, lane = tid & 63;
    for (int row = blockIdx.x * 8 + wid; row < NTOK; row += gridDim.x * 8) {
        float part = lane < 16 ? p.rowss[(size_t)row * 16 + lane] : 0.f;
        part = wave_sum(part);
        const float rstd = rsqrtf(part * (1.0f / DM) + 1e-6f);
        float* orow = p.out + (size_t)row * DM;
#pragma unroll
        for (int j = 0; j < 2; ++j) { const int c = j * 512 + lane * 8;
            const f32x4 a = *(const f32x4*)(orow + c), b = *(const f32x4*)(orow + c + 4), g0 = *(const f32x4*)(p.fin_g + c), g1 = *(const f32x4*)(p.fin_g + c + 4);
            *(f32x4*)(orow + c) = a * rstd * g0; *(f32x4*)(orow + c + 4) = b * rstd * g1; }
    }
}

template <int PH> __global__ void __launch_bounds__(512, 2) fwd_kernel(Params p) {
    extern __shared__ __attribute__((aligned(16))) unsigned char shm[];
    LAS unsigned char* lds = (LAS unsigned char*)shm;
    if constexpr (PH & 1) prep_phase(p, lds);
    if constexpr ((PH & 1) && (PH & 2)) cg::this_grid().sync();
    if constexpr (PH & 2) { pg8::Gemm g{p.H, p.WinT, NTOK, INC, DM}; pg8::StaticOrder S; S.init(NTOK, INC, (int)gridDim.x, (int)blockIdx.x); EpiProj E{p.PROJ};
        pg8::gemm_phase<EpiProj, pg8::StaticOrder, false>(lds, g, S, E, nullptr); }
    if constexpr ((PH & 2) && (PH & 4)) cg::this_grid().sync();
    if constexpr (PH & 4) {
#ifndef NO_ATTN
        attn_phase(p, lds); __syncthreads();
#endif
#ifndef NO_CONV
        conv_phase(p, lds);
#endif
    }
    if constexpr ((PH & 4) && (PH & 8)) cg::this_grid().sync();
    if constexpr (PH & 8) { __syncthreads(); pg8::Gemm g{p.Y, p.WoutT, NTOK, DM, MIXW}; pg8::StaticOrder S; S.init(NTOK, DM, (int)gridDim.x, (int)blockIdx.x); EpiOut E{p.x, p.out, p.rowss};
        pg8::gemm_phase<EpiOut, pg8::StaticOrder, false>(lds, g, S, E, nullptr); }
    if constexpr ((PH & 8) && (PH & 16)) cg::this_grid().sync();
    if constexpr (PH & 16) final_phase(p);
}

#ifndef N_LAUNCH_MODE
#define N_LAUNCH_MODE 1
#endif
extern "C" void kernel_launch(void* const* d_in, const int* in_sizes, int n_in, void* d_out, int out_size, void* d_ws, size_t ws_size, hipStream_t stream) {
    (void)in_sizes; (void)n_in; (void)out_size;
    Params p{};
    p.x = (const float*)d_in[0]; p.norm_g = (const float*)d_in[1]; p.w_in = (const float*)d_in[2]; p.conv_w = (const float*)d_in[3]; p.conv_b = (const float*)d_in[4];
    p.ln_g = (const float*)d_in[5]; p.ln_b = (const float*)d_in[6]; p.w_out = (const float*)d_in[7]; p.fin_g = (const float*)d_in[8];
    p.out = (float*)d_out;
    p.H = (bf16_t*)d_out;
    char* ws = (char*)d_ws; size_t off = 0;
    p.PROJ = (bf16_t*)(ws + off); off += (size_t)NTOK * INC * 2;
    p.Y = (bf16_t*)(ws + off); off += (size_t)NTOK * MIXW * 2;
    p.WinT = (bf16_t*)(ws + off); off += (size_t)INC * DM * 2;
    p.WoutT = (bf16_t*)(ws + off); off += (size_t)DM * MIXW * 2;
    p.rowss = (float*)(ws + off); off += (size_t)NTOK * 16 * 4;
    if (off > ws_size) { fprintf(stderr, "kernel_launch: workspace too small (%zu needed, %zu given)\n", off, ws_size); return; }
    static int grid = 0;
    if (!grid) {
        int dev = 0, cus = 0, per_cu = 0; hipGetDevice(&dev); hipDeviceGetAttribute(&cus, hipDeviceAttributeMultiprocessorCount, dev);
        hipFuncSetAttribute((const void*)fwd_kernel<31>, hipFuncAttributeMaxDynamicSharedMemorySize, LDS_BYTES);
        hipFuncSetAttribute((const void*)fwd_kernel<1>, hipFuncAttributeMaxDynamicSharedMemorySize, LDS_BYTES);
        hipFuncSetAttribute((const void*)fwd_kernel<2>, hipFuncAttributeMaxDynamicSharedMemorySize, LDS_BYTES);
        hipFuncSetAttribute((const void*)fwd_kernel<4>, hipFuncAttributeMaxDynamicSharedMemorySize, LDS_BYTES);
        hipFuncSetAttribute((const void*)fwd_kernel<8>, hipFuncAttributeMaxDynamicSharedMemorySize, LDS_BYTES);
        hipFuncSetAttribute((const void*)fwd_kernel<16>, hipFuncAttributeMaxDynamicSharedMemorySize, LDS_BYTES);
        hipOccupancyMaxActiveBlocksPerMultiprocessor(&per_cu, (const void*)fwd_kernel<31>, 512, LDS_BYTES);
        if (per_cu < 1) { fprintf(stderr, "kernel_launch: occupancy query says 0 blocks/CU\n"); per_cu = 1; }
        grid = cus * per_cu;
    }
#if N_LAUNCH_MODE == 1
    void* args[] = {&p};
    hipError_t e = hipLaunchCooperativeKernel((const void*)fwd_kernel<31>, dim3(grid), dim3(512), args, LDS_BYTES, stream);
    if (e != hipSuccess) fprintf(stderr, "cooperative launch failed: %s (grid %d)\n", hipGetErrorString(e), grid);
#else
    hipLaunchKernelGGL(fwd_kernel<1>, dim3(grid), dim3(512), LDS_BYTES, stream, p);
    hipLaunchKernelGGL(fwd_kernel<2>, dim3(grid), dim3(512), LDS_BYTES, stream, p);
    hipLaunchKernelGGL(fwd_kernel<4>, dim3(grid), dim3(512), LDS_BYTES, stream, p);
    hipLaunchKernelGGL(fwd_kernel<8>, dim3(grid), dim3(512), LDS_BYTES, stream, p);
    hipLaunchKernelGGL(fwd_kernel<16>, dim3(grid), dim3(512), LDS_BYTES, stream, p);
#endif
}
```

```cpp
#include <hip/hip_runtime.h>
#include <hip/hip_cooperative_groups.h>
#include <cstdio>
#include <cstdint>
namespace cg = cooperative_groups;
#define XB_TMO      128
#define XB_XCNT(j)  (256  + 64 * (j))
#define XB_XSUB(j)  (1280 + 64 * (j))
#define XB_XGEN(j)  (2304 + 64 * (j))
#define XB_TOP      3328
#define XB_TOPGEN   3392
#define XCD_BAR_WORDS 3456
#define XB_SPIN_CAP (1u << 18)
#define LAS __attribute__((address_space(3)))

__device__ __forceinline__ unsigned xb_ld(unsigned* p)              { return __hip_atomic_load(p, __ATOMIC_RELAXED, __HIP_MEMORY_SCOPE_AGENT); }
__device__ __forceinline__ unsigned xb_add(unsigned* p, unsigned v) { return __hip_atomic_fetch_add(p, v, __ATOMIC_RELAXED, __HIP_MEMORY_SCOPE_AGENT); }
__device__ __forceinline__ unsigned xb_xcc_id() { return (unsigned)__builtin_amdgcn_s_getreg((3 << 11) | 20) & 0xFu; }
#define XB_SPIN(cond, bar) do { unsigned _sp = 0; while (cond) { __builtin_amdgcn_s_sleep(1); \
    if ((++_sp & 255u) == 0u) { if (xb_ld(&(bar)[XB_TMO])) break; if (_sp > XB_SPIN_CAP) { atomicAdd(&(bar)[XB_TMO], 1u); break; } } } } while (0)

struct XcdBarrier {
    unsigned* bar; unsigned x;
    volatile LAS unsigned* st;
};

__device__ __forceinline__ XcdBarrier xcd_barrier_post(unsigned* bar, volatile LAS unsigned* st) {
    XcdBarrier b; b.bar = bar; b.x = xb_xcc_id(); b.st = st;
    if (threadIdx.x == 0) (void)xb_add(&bar[XB_XCNT(b.x)], 1u);
    return b;
}
__device__ __forceinline__ void xcd_barrier_complete(unsigned* bar, unsigned x, unsigned& nloc, unsigned& nx) {
    const unsigned G = gridDim.x * gridDim.y * gridDim.z;
    unsigned sum, cnt, mine, sp = 0u;
    for (;;) {
        sum = 0u; cnt = 0u; mine = 0u;
#pragma unroll
        for (unsigned j = 0; j < 16; ++j) { const unsigned c = xb_ld(&bar[XB_XCNT(j)]); sum += c; cnt += (c > 0u) ? 1u : 0u; mine = (j == x) ? c : mine; }
        if (sum == G) break;
        __builtin_amdgcn_s_sleep(1);
        if ((++sp & 255u) == 0u) { if (xb_ld(&bar[XB_TMO])) break; if (sp > XB_SPIN_CAP) { atomicAdd(&bar[XB_TMO], 1u); break; } }
    }
    nloc = mine > 0u ? mine : 1u; nx = cnt > 0u ? cnt : 1u;
}

__device__ __forceinline__ void xcd_barrier(const XcdBarrier& b) {
    asm volatile("s_waitcnt vmcnt(0)" ::: "memory");
    __syncthreads();
    if (threadIdx.x == 0) {
        unsigned* bar = b.bar;
        __builtin_amdgcn_s_waitcnt(0);
        unsigned nloc = b.st[0], nx = b.st[1];
        if (nloc == 0u) { xcd_barrier_complete(bar, b.x, nloc, nx); b.st[0] = nloc; b.st[1] = nx; }
        const unsigned old = xb_add(&bar[XB_XSUB(b.x)], 1u);
        const unsigned gen = old / nloc;
        if (old + 1u == (gen + 1u) * nloc) {
            __builtin_amdgcn_fence(__ATOMIC_RELEASE, "agent");
            asm volatile("s_waitcnt vmcnt(0)" ::: "memory");
            const unsigned og = xb_add(&bar[XB_TOP], 1u);
            const unsigned tg = og / nx;
            if (og + 1u == (tg + 1u) * nx) xb_add(&bar[XB_TOPGEN], 1u);
            else XB_SPIN(xb_ld(&bar[XB_TOPGEN]) == tg, bar);
            __builtin_amdgcn_fence(__ATOMIC_ACQUIRE, "agent");
            xb_add(&bar[XB_XGEN(b.x)], 1u);
            asm volatile("s_waitcnt vmcnt(0)" ::: "memory");
        } else {
            XB_SPIN(xb_ld(&bar[XB_XGEN(b.x)]) == gen, bar);
            __builtin_amdgcn_fence(__ATOMIC_ACQUIRE, "agent");
            asm volatile("s_waitcnt vmcnt(0)" ::: "memory");
        }
    }
    __syncthreads();
}
namespace pg8 {
#define PG8_LAS __attribute__((address_space(3)))
typedef unsigned short bf16_t;
typedef short bf16x8 __attribute__((ext_vector_type(8)));
typedef float f32x4 __attribute__((ext_vector_type(4)));
typedef unsigned u32x4 __attribute__((ext_vector_type(4)));
constexpr int BM = 256, BK = 64, HALF = 128, HTB = HALF * BK * 2  , STAGE_BYTES = 8 * HTB, NXCD = 8, WGM = 8;

__host__ __device__ __forceinline__ int lds_byte(int r, int c) { const int st = (r >> 4) * 2 + (c >> 5), rr = r & 15, cc = c & 31, ob = rr * 64 + cc * 2; return st * 1024 + (ob ^ (((ob >> 9) & 1) << 5)); }
__host__ __device__ __forceinline__ void stage_rc(int b, int& R, int& C) { const int st = b / 1024, sb = b % 1024, swz = sb ^ (((sb >> 9) & 1) << 5); R = (st >> 1) * 16 + swz / 64; C = (st & 1) * 32 + (swz % 64) / 2; }
__host__ __device__ __forceinline__ int perm32(int rho) { const int n = rho >> 4, i = rho & 15; return 8 * (i >> 2) + 4 * n + (i & 3); }

struct Unit { int pm, pn; };
struct Gemm { const bf16_t* A; const bf16_t* Bt; int M, N, K; };

struct StaticOrder {
    int nM, nN, nwg, G, c;
    __host__ __device__ void init(int M, int N, int G_, int c_) { nM = M / BM; nN = N / BM; nwg = nM * nN; G = G_; c = c_; }
    __host__ __device__ bool next(int i, Unit& u) const {
        const long L = (long)i * G + c; if (L >= nwg) return false;
        int wgid = (int)L; { const int q = nwg / NXCD, r = nwg % NXCD, xcd = wgid % NXCD, off = wgid / NXCD; wgid = (xcd < r ? xcd * (q + 1) : r * (q + 1) + (xcd - r) * q) + off; }
        const int nig = WGM * nN, gid = wgid / nig, fm = gid * WGM, gsz = (nM - fm) < WGM ? (nM - fm) : WGM;
        u.pm = fm + ((wgid % nig) % gsz); u.pn = (wgid % nig) / gsz; return true;
    }
    __device__ __forceinline__ void a_ready(const Unit&) const {}
    __device__ __forceinline__ void done(const Unit&) const {}
};
__device__ __forceinline__ unsigned cvt_pk_bf16(float lo, float hi) { unsigned r; asm volatile("v_cvt_pk_bf16_f32 %0, %1, %2" : "=v"(r) : "v"(lo), "v"(hi)); return r; }
typedef float f32x2 __attribute__((ext_vector_type(2)));
template <class Epi, class Sched, bool STAMP = false>
__device__ __forceinline__ void gemm_phase(PG8_LAS unsigned char* lds, const Gemm g, const Sched& S, const Epi& E, unsigned long long* stamps) {
    const int tid = threadIdx.x, wid = __builtin_amdgcn_readfirstlane(tid >> 6), lane = tid & 63, wr = wid >> 2, wc = wid & 3, fr = lane & 15, fq = lane >> 4;
    const int K = g.K, nt = K / BK;
    int ts_lo = 0, ts_hi = 0, nts = 0; const unsigned long long rt_entry = STAMP ? (unsigned long long)wall_clock64() : 0ull;
#define PG8_STAMP() do { if (STAMP && wid == 0 && nts < 64) { const unsigned long long _c = (unsigned long long)clock64(); \
        ts_lo = (lane == nts) ? (int)(unsigned)_c : ts_lo; ts_hi = (lane == nts) ? (int)(unsigned)(_c >> 32) : ts_hi; ++nts; } } while (0)
    PG8_STAMP();
    unsigned voffA[2], voffB[2];
#pragma unroll
    for (int i = 0; i < 2; ++i) { int R, C; stage_rc(tid * 16 + i * 8192, R, C); const int Rb = Epi::PERM ? ((R & ~31) + perm32(R & 31)) : R;
        voffA[i] = (unsigned)(R * K + C) * 2u; voffB[i] = (unsigned)(Rb * K + C) * 2u; }
    const size_t kstep = (size_t)(BK * 2);
    const size_t hstep = (size_t)HALF * K * 2;
    const size_t tstep = 2 * hstep;
    const unsigned ldsw = (unsigned)wid * 1024u;
    const int aoff = lds_byte(wr * 64 + fr, fq * 8), boff = lds_byte(wc * 32 + fr, fq * 8);
#define PG8_SA(b, h) (((b) * 2 + (h)) * HTB)
#define PG8_SB(b, h) ((4 + (b) * 2 + (h)) * HTB)
#define PG8_STAGE(bufoff, gbase, voff) do { _Pragma("unroll") for (int _i = 0; _i < 2; ++_i) \
        __builtin_amdgcn_global_load_lds((const unsigned*)((const char*)(gbase) + (voff)[_i]), (PG8_LAS unsigned*)(lds + (bufoff) + ldsw + _i * 8192), 16, 0, 0); } while (0)
#define PG8_LDA(dst, b, h) do { _Pragma("unroll") for (int m = 0; m < 4; ++m) _Pragma("unroll") for (int k = 0; k < 2; ++k) dst[m][k] = *(const PG8_LAS bf16x8*)(lds + PG8_SA(b, h) + aoff + m * 2048 + k * 1024); } while (0)
#define PG8_LDB(dst, b, h) do { _Pragma("unroll") for (int n = 0; n < 2; ++n) _Pragma("unroll") for (int k = 0; k < 2; ++k) dst[n][k] = *(const PG8_LAS bf16x8*)(lds + PG8_SB(b, h) + boff + n * 2048 + k * 1024); } while (0)
#define PG8_MMA(ai, bj, At, Bt) do { __builtin_amdgcn_s_setprio(1); _Pragma("unroll") for (int m = 0; m < 4; ++m) _Pragma("unroll") for (int n = 0; n < 2; ++n) _Pragma("unroll") for (int k = 0; k < 2; ++k) \
        acc[ai][bj][m][n] = __builtin_amdgcn_mfma_f32_16x16x32_bf16(Bt[n][k], At[m][k], acc[ai][bj][m][n], 0, 0, 0); __builtin_amdgcn_s_setprio(0); } while (0)
#define PG8_WAIT_V(n) asm volatile("s_waitcnt vmcnt(" #n ")" ::: "memory")
#define PG8_WAIT_L(n) asm volatile("s_waitcnt lgkmcnt(" #n ")" ::: "memory")
#define PG8_BAR __builtin_amdgcn_s_barrier()
#define PG8_SCHED __builtin_amdgcn_sched_barrier(0)
    Unit cur, nxt; int ui = 0;
    if (!S.next(0, cur)) return;
    f32x4 acc[2][2][4][2];
#pragma unroll
    for (int a = 0; a < 2; ++a)
#pragma unroll
        for (int b = 0; b < 2; ++b)
#pragma unroll
            for (int m = 0; m < 4; ++m)
#pragma unroll
                for (int n = 0; n < 2; ++n) acc[a][b][m][n] = (f32x4){0.f, 0.f, 0.f, 0.f};
    bf16x8 At[4][2], B0[2][2], B1[2][2];
    const char* cA = (const char*)g.A + (size_t)cur.pm * tstep; const char* cB = (const char*)g.Bt + (size_t)cur.pn * tstep;
    S.a_ready(cur);
    PG8_STAGE(PG8_SB(0, 0), cB, voffB); PG8_STAGE(PG8_SA(0, 0), cA, voffA); PG8_STAGE(PG8_SB(0, 1), cB + hstep, voffB); PG8_STAGE(PG8_SA(0, 1), cA + hstep, voffA);
    if (wr == 1) PG8_BAR;
    PG8_WAIT_V(4); PG8_BAR;
    PG8_STAGE(PG8_SB(1, 0), cB + kstep, voffB); PG8_STAGE(PG8_SA(1, 0), cA + kstep, voffA); PG8_STAGE(PG8_SB(1, 1), cB + hstep + kstep, voffB);
    PG8_WAIT_V(6); PG8_BAR;
    PG8_STAMP();
    for (;;) {
        const bool has_next = S.next(ui + 1, nxt);
        const char* nA = has_next ? (const char*)g.A + (size_t)nxt.pm * tstep : cA; const char* nB = has_next ? (const char*)g.Bt + (size_t)nxt.pn * tstep : cB;
        for (int t = 0; t < nt; t += 2) {
            const bool last = (t == nt - 2);
            const char* a1 = cA + (size_t)(t + 1) * kstep;
            const char* a2 = last ? nA : cA + (size_t)(t + 2) * kstep; const char* b2 = last ? nB : cB + (size_t)(t + 2) * kstep;
            const char* a3 = a2 + kstep; const char* b3 = b2 + kstep;
            if (last && has_next) S.a_ready(nxt);
            PG8_LDB(B0, 0, 0); PG8_SCHED; PG8_LDA(At, 0, 0); PG8_STAGE(PG8_SA(1, 1), a1 + hstep, voffA);
            PG8_WAIT_L(8); PG8_BAR; PG8_WAIT_L(0); PG8_MMA(0, 0, At, B0); PG8_BAR; PG8_SCHED;
            PG8_LDB(B1, 0, 1); PG8_STAGE(PG8_SB(0, 0), b2, voffB);
            PG8_BAR; PG8_WAIT_L(0); PG8_MMA(0, 1, At, B1); PG8_BAR;
            PG8_LDA(At, 0, 1); PG8_STAGE(PG8_SA(0, 0), a2, voffA);
            PG8_BAR; PG8_WAIT_L(0); PG8_MMA(1, 0, At, B0); PG8_BAR; PG8_SCHED;
            PG8_STAGE(PG8_SB(0, 1), b2 + hstep, voffB);
            PG8_WAIT_V(6); PG8_BAR; PG8_MMA(1, 1, At, B1); PG8_BAR;
            PG8_LDB(B0, 1, 0); PG8_SCHED; PG8_LDA(At, 1, 0); PG8_STAGE(PG8_SA(0, 1), a2 + hstep, voffA);
            PG8_WAIT_L(8); PG8_BAR; PG8_WAIT_L(0); PG8_MMA(0, 0, At, B0); PG8_BAR; PG8_SCHED;
            PG8_LDB(B1, 1, 1); PG8_STAGE(PG8_SB(1, 0), b3, voffB);
            PG8_BAR; PG8_WAIT_L(0); PG8_MMA(0, 1, At, B1); PG8_BAR;
            PG8_LDA(At, 1, 1); PG8_STAGE(PG8_SA(1, 0), a3, voffA);
            PG8_BAR; PG8_WAIT_L(0); PG8_MMA(1, 0, At, B0); PG8_BAR; PG8_SCHED;
            PG8_STAGE(PG8_SB(1, 1), b3 + hstep, voffB);
            PG8_WAIT_V(6); PG8_BAR; PG8_MMA(1, 1, At, B1); PG8_BAR;
        }
        PG8_STAMP();
        if constexpr (!Epi::AFTER_DRAIN) { E(acc, cur, wr, wc, fr, fq); S.done(cur); }
        PG8_STAMP();
        if (!has_next) break;
#pragma unroll
        for (int a = 0; a < 2; ++a)
#pragma unroll
            for (int b = 0; b < 2; ++b)
#pragma unroll
                for (int m = 0; m < 4; ++m)
#pragma unroll
                    for (int n = 0; n < 2; ++n) acc[a][b][m][n] = (f32x4){0.f, 0.f, 0.f, 0.f};
        cur = nxt; cA = nA; cB = nB; ++ui;
    }
    PG8_WAIT_V(0);
    if (wr == 0) PG8_BAR;
    PG8_BAR;
    if constexpr (Epi::AFTER_DRAIN) { E.fused(acc, cur, wr, wc, fr, fq, lds, wid, lane); S.done(cur); }
    PG8_STAMP();
    if (STAMP && wid == 0) { stamps[lane] = lane < nts ? (((unsigned long long)(unsigned)ts_hi << 32) | (unsigned)ts_lo) : 0ull;
        if (lane == 62) stamps[62] = rt_entry; if (lane == 63) stamps[63] = (unsigned long long)wall_clock64(); }
#undef PG8_STAMP
#undef PG8_SA
#undef PG8_SB
#undef PG8_STAGE
#undef PG8_LDA
#undef PG8_LDB
#undef PG8_MMA
#undef PG8_WAIT_V
#undef PG8_WAIT_L
#undef PG8_BAR
#undef PG8_SCHED
}
}
using pg8::bf16_t; using pg8::bf16x8; using pg8::f32x4; using pg8::u32x4;
typedef float f32x16 __attribute__((ext_vector_type(16)));
typedef short s16x4 __attribute__((ext_vector_type(4)));
typedef float f32x2v __attribute__((ext_vector_type(2)));
typedef unsigned u32x2 __attribute__((ext_vector_type(2)));
typedef __bf16 bf2_t __attribute__((ext_vector_type(2)));
#define DI __device__ __forceinline__

constexpr int BATCH = 8, SEQ = 4096, DM = 1024, NTOK = BATCH * SEQ, INC = 5632, MIXW = 2048;
constexpr int COL_K = 1024, COL_V = 1280, COL_AG = 1536, COL_CV = 2560, COL_CG = 3584, COL_CGATE = 4608;
constexpr float LOG2E = 1.4426950408889634f;
constexpr float QSCALE = 0.125f * LOG2E;
constexpr int LDS_BYTES = 131072;

struct Params {
    const float* x; const float* norm_g; const float* w_in; const float* conv_w; const float* conv_b; const float* ln_g; const float* ln_b; const float* w_out; const float* fin_g;
    float* out; bf16_t* H; bf16_t* WinT; bf16_t* WoutT; bf16_t* PROJ; bf16_t* Y; float* rowss;
    unsigned* bar; int rep_conv, rep_sync;
};

DI float fexp2(float x) { return __builtin_amdgcn_exp2f(x); }
DI float frcp(float x) { return __builtin_amdgcn_rcpf(x); }
DI float sigm(float x) { return frcp(1.0f + fexp2(-x * LOG2E)); }
DI float silu(float x) { return x * sigm(x); }
DI unsigned pk_bf16(float a, float b) { f32x2v v = {a, b}; bf2_t r = __builtin_convertvector(v, bf2_t); return __builtin_bit_cast(unsigned, r); }
DI float bf_lo(unsigned w) { return __uint_as_float(w << 16); }
DI float bf_hi(unsigned w) { return __uint_as_float(w & 0xffff0000u); }
DI float wave_sum(float v) { for (int o = 32; o >= 1; o >>= 1) v += __shfl_xor(v, o); return v; }

struct EpiProj {
    static constexpr bool PERM = true, AFTER_DRAIN = false;
    bf16_t* O;
    __device__ __forceinline__ void operator()(const f32x4 (&acc)[2][2][4][2], const pg8::Unit& u, int wr, int wc, int fr, int fq) const {
        const int row0 = u.pm * 256 + wr * 64 + fr, col0 = u.pn * 256 + wc * 32 + 8 * fq, pn = u.pn;
        const int mode = pn < 4 ? 1 : pn < 6 ? 0 : pn < 10 ? 2 : pn < 14 ? 0 : pn < 18 ? 3 : 2;
#pragma unroll
        for (int ai = 0; ai < 2; ++ai)
#pragma unroll
            for (int m = 0; m < 4; ++m) { bf16_t* rowp = O + (size_t)(row0 + ai * 128 + m * 16) * INC + col0;
#pragma unroll
                for (int bj = 0; bj < 2; ++bj) { float v[8];
#pragma unroll
                    for (int j = 0; j < 4; ++j) { v[j] = acc[ai][bj][m][0][j]; v[4 + j] = acc[ai][bj][m][1][j]; }
                    if (mode == 1) {
#pragma unroll
                        for (int j = 0; j < 8; ++j) v[j] *= QSCALE;
                    } else if (mode == 2) {
#pragma unroll
                        for (int j = 0; j < 8; ++j) v[j] = silu(v[j]);
                    } else if (mode == 3) {
#pragma unroll
                        for (int j = 0; j < 8; ++j) v[j] = sigm(v[j]);
                    }
                    u32x4 w; w.x = pk_bf16(v[0], v[1]); w.y = pk_bf16(v[2], v[3]); w.z = pk_bf16(v[4], v[5]); w.w = pk_bf16(v[6], v[7]);
                    *(u32x4*)(rowp + bj * 128) = w; } }
    }
};
struct EpiOut {
    static constexpr bool PERM = false, AFTER_DRAIN = false;
    const float* X; float* out; float* rowss;
    __device__ __forceinline__ void operator()(const f32x4 (&acc)[2][2][4][2], const pg8::Unit& u, int wr, int wc, int fr, int fq) const {
        const int row0 = u.pm * 256 + wr * 64 + fr, col0 = u.pn * 256 + wc * 32 + 4 * fq;
#pragma unroll
        for (int ai = 0; ai < 2; ++ai)
#pragma unroll
            for (int m = 0; m < 4; ++m) { const int r = row0 + ai * 128 + m * 16; const size_t off = (size_t)r * DM + col0; float ss = 0.f;
#pragma unroll
                for (int bj = 0; bj < 2; ++bj)
#pragma unroll
                    for (int n = 0; n < 2; ++n) { const f32x4 xv = *(const f32x4*)(X + off + bj * 128 + n * 16); const f32x4 z = xv + acc[ai][bj][m][n];
                        *(f32x4*)(out + off + bj * 128 + n * 16) = z; ss += (z[0] * z[0] + z[1] * z[1]) + (z[2] * z[2] + z[3] * z[3]); }
                ss += __shfl_xor(ss, 16); ss += __shfl_xor(ss, 32);
                if (fq == 0) rowss[(size_t)r * 16 + u.pn * 4 + wc] = ss;
                asm volatile("" ::: "memory"); }
    }
};

DI void prep_phase(const Params& p, LAS unsigned char* lds) {
    const int tid = threadIdx.x, wid = tid >> 6, lane = tid & 63;
    for (int row = blockIdx.x * 8 + wid; row < NTOK; row += gridDim.x * 8) {
        const float* xr = p.x + (size_t)row * DM;
        f32x4 v[4]; float ss = 0.f;
#pragma unroll
        for (int j = 0; j < 2; ++j) { v[2 * j] = *(const f32x4*)(xr + j * 512 + lane * 8); v[2 * j + 1] = *(const f32x4*)(xr + j * 512 + lane * 8 + 4); }
#pragma unroll
        for (int j = 0; j < 4; ++j) ss += (v[j][0] * v[j][0] + v[j][1] * v[j][1]) + (v[j][2] * v[j][2] + v[j][3] * v[j][3]);
        ss = wave_sum(ss);
        const float rstd = rsqrtf(ss * (1.0f / DM) + 1e-6f);
#pragma unroll
        for (int j = 0; j < 2; ++j) { const f32x4 g0 = *(const f32x4*)(p.norm_g + j * 512 + lane * 8), g1 = *(const f32x4*)(p.norm_g + j * 512 + lane * 8 + 4);
            const f32x4 a = v[2 * j] * rstd * g0, b = v[2 * j + 1] * rstd * g1;
            u32x4 w; w.x = pk_bf16(a[0], a[1]); w.y = pk_bf16(a[2], a[3]); w.z = pk_bf16(b[0], b[1]); w.w = pk_bf16(b[2], b[3]);
            *(u32x4*)(p.H + (size_t)row * DM + j * 512 + lane * 8) = w; }
    }
    LAS float* tile = (LAS float*)lds;
    for (int t = blockIdx.x; t < 1408 + 512; t += gridDim.x) {
        const float* src; bf16_t* dst; int ldS, ldD;
        if (t < 1408) { const int kt = t / 88, nt = t % 88; src = p.w_in + (size_t)kt * 64 * INC + nt * 64; ldS = INC; dst = p.WinT + (size_t)nt * 64 * DM + kt * 64; ldD = DM; }
        else { const int t2 = t - 1408, kt = t2 / 16, nt = t2 % 16; src = p.w_out + (size_t)kt * 64 * DM + nt * 64; ldS = DM; dst = p.WoutT + (size_t)nt * 64 * MIXW + kt * 64; ldD = MIXW; }
#pragma unroll
        for (int e = 0; e < 8; ++e) { const int idx = tid + 512 * e, k = idx >> 6, n = idx & 63; tile[k * 65 + n] = src[(size_t)k * ldS + n]; }
        __syncthreads();
        { const int n = tid >> 3, kc = (tid & 7) * 8; float f[8];
#pragma unroll
          for (int j = 0; j < 8; ++j) f[j] = tile[(kc + j) * 65 + n];
          u32x4 w; w.x = pk_bf16(f[0], f[1]); w.y = pk_bf16(f[2], f[3]); w.z = pk_bf16(f[4], f[5]); w.w = pk_bf16(f[6], f[7]);
          *(u32x4*)(dst + (size_t)n * ldD + kc) = w; }
        __syncthreads();
    }
}

DI void attn_issue_k(const char* kbase, int utop, int tix, int n, bf16x8 (&k)[4]) {
    tix = tix < 17 ? tix : 17;
    const int d = tix < 5 ? 16 : tix < 10 ? 4 : 1, tau = tix < 5 ? tix : tix < 10 ? tix - 5 : tix - 10;
    int uk = utop - d * (32 * tau + n); uk = uk < 0 ? 0 : uk;
    const char* kp = kbase + (size_t)__umul24((unsigned)uk, (unsigned)(INC * 2));
#pragma unroll
    for (int s = 0; s < 4; ++s) k[s] = *(const bf16x8*)(kp + 32 * s);
}
DI void attn_issue_v(const char* vbase, int utop, int tix, int lane, LAS unsigned char* vring) {
    tix = tix < 17 ? tix : 17;
    const int d = tix < 5 ? 16 : tix < 10 ? 4 : 1, tau = tix < 5 ? tix : tix < 10 ? tix - 5 : tix - 10;
    LAS unsigned char* dst = vring + (tix & 3) * 4096;
#pragma unroll
    for (int j = 0; j < 4; ++j) { int uv = utop - d * (32 * tau + 8 * j + (lane >> 3)); uv = uv < 0 ? 0 : uv;
        __builtin_amdgcn_global_load_lds((const unsigned*)(vbase + (size_t)__umul24((unsigned)uv, (unsigned)(INC * 2))), (LAS unsigned*)(dst + j * 1024), 16, 0, 0); }
}
constexpr float ATT_THR = 8.0f;
DI void attn_tile_a(const bool MASKED, const int D, const bf16x8 (&kf)[4], const bf16x8 (&qf)[4], f32x16& sa, const float mrow, int D0, int lim, float nsl) {
    const float A = nsl * (float)D0 - mrow, step = nsl * (float)D;
    { const f32x2v b01 = {A, A + step}; const f32x2v b23 = b01 + 2.f * step;
#pragma unroll
      for (int gq = 0; gq < 4; ++gq) { const f32x2v x = b01 + (8.f * gq) * step, y = b23 + (8.f * gq) * step; sa[4 * gq] = x[0]; sa[4 * gq + 1] = x[1]; sa[4 * gq + 2] = y[0]; sa[4 * gq + 3] = y[1]; } }
    if (MASKED) {
#pragma unroll
        for (int i = 0; i < 16; ++i) { const int ci = (i & 3) + 8 * (i >> 2); const bool valid = (unsigned)(D0 + D * ci) <= (unsigned)lim; sa[i] = valid ? sa[i] : -__builtin_inff(); }
    }
#pragma unroll
    for (int s = 0; s < 4; ++s) sa = __builtin_amdgcn_mfma_f32_32x32x16_bf16(kf[s], qf[s], sa, 0, 0, 0);
}
DI void attn_tile_b(const bool first, f32x16& sa, f32x16& o0, f32x16& o1, float& mrow, float& lrow, unsigned ta0, unsigned ta1) {
    float pmax = fmaxf(fmaxf(sa[0], sa[1]), sa[2]);
#pragma unroll
    for (int i = 3; i < 15; i += 2) pmax = fmaxf(fmaxf(pmax, sa[i]), sa[i + 1]);
    pmax = fmaxf(pmax, sa[15]);
    { auto rr = __builtin_amdgcn_permlane32_swap(__float_as_uint(pmax), __float_as_uint(pmax), false, false); pmax = fmaxf(__uint_as_float(rr[0]), __uint_as_float(rr[1])); }
    if (first || !__all(pmax <= ATT_THR)) {
        const float delta = first ? pmax : fmaxf(pmax, 0.f), alpha = first ? 1.f : fexp2(-delta);
#pragma unroll
        for (int i = 0; i < 16; ++i) { sa[i] -= delta; o0[i] *= alpha; o1[i] *= alpha; }
        lrow *= alpha; mrow += delta;
    }
    f32x2v rs2 = {0.f, 0.f};
#pragma unroll
    for (int i = 0; i < 16; i += 2) { sa[i] = fexp2(sa[i]); sa[i + 1] = fexp2(sa[i + 1]); const f32x2v pp = {sa[i], sa[i + 1]}; rs2 += pp; }
    float rs = rs2[0] + rs2[1];
    { auto rr = __builtin_amdgcn_permlane32_swap(__float_as_uint(rs), __float_as_uint(rs), false, false); rs = __uint_as_float(rr[0]) + __uint_as_float(rr[1]); }
    lrow += rs;
    u32x4 pw0, pw1;
    pw0.x = pk_bf16(sa[0], sa[1]); pw0.y = pk_bf16(sa[2], sa[3]); pw0.z = pk_bf16(sa[4], sa[5]); pw0.w = pk_bf16(sa[6], sa[7]);
    pw1.x = pk_bf16(sa[8], sa[9]); pw1.y = pk_bf16(sa[10], sa[11]); pw1.z = pk_bf16(sa[12], sa[13]); pw1.w = pk_bf16(sa[14], sa[15]);
    const bf16x8 pf0 = __builtin_bit_cast(bf16x8, pw0), pf1 = __builtin_bit_cast(bf16x8, pw1);
    s16x4 t0, t1, t2, t3, t4, t5, t6, t7;
    asm volatile("s_waitcnt vmcnt(24)\n\t"
                 "ds_read_b64_tr_b16 %0, %8\n\t"
                 "ds_read_b64_tr_b16 %1, %8 offset:1024\n\t"
                 "ds_read_b64_tr_b16 %2, %8 offset:2048\n\t"
                 "ds_read_b64_tr_b16 %3, %8 offset:3072\n\t"
                 "ds_read_b64_tr_b16 %4, %9\n\t"
                 "ds_read_b64_tr_b16 %5, %9 offset:1024\n\t"
                 "ds_read_b64_tr_b16 %6, %9 offset:2048\n\t"
                 "ds_read_b64_tr_b16 %7, %9 offset:3072\n\t"
                 "s_waitcnt lgkmcnt(0)"
                 : "=&v"(t0), "=&v"(t1), "=&v"(t2), "=&v"(t3), "=&v"(t4), "=&v"(t5), "=&v"(t6), "=&v"(t7) : "v"(ta0), "v"(ta1) : "memory");
    const bf16x8 v00 = __builtin_shufflevector(t0, t1, 0, 1, 2, 3, 4, 5, 6, 7), v01 = __builtin_shufflevector(t2, t3, 0, 1, 2, 3, 4, 5, 6, 7);
    const bf16x8 v10 = __builtin_shufflevector(t4, t5, 0, 1, 2, 3, 4, 5, 6, 7), v11 = __builtin_shufflevector(t6, t7, 0, 1, 2, 3, 4, 5, 6, 7);
    o0 = __builtin_amdgcn_mfma_f32_32x32x16_bf16(v00, pf0, o0, 0, 0, 0);
    o0 = __builtin_amdgcn_mfma_f32_32x32x16_bf16(v01, pf1, o0, 0, 0, 0);
    o1 = __builtin_amdgcn_mfma_f32_32x32x16_bf16(v10, pf0, o1, 0, 0, 0);
    o1 = __builtin_amdgcn_mfma_f32_32x32x16_bf16(v11, pf1, o1, 0, 0, 0);
}
#define ATT_STEP(TIX_, KCUR_, KNXT_) { const int tix_ = (TIX_); \
    const int d_ = tix_ < 5 ? 16 : tix_ < 10 ? 4 : 1, tau_ = tix_ < 5 ? tix_ : tix_ < 10 ? tix_ - 5 : tix_ - 10; \
    const int D0_ = dq + d_ * (32 * tau_ + 4 * h); const int lim_ = (128 * d_) < tq ? (128 * d_) : tq; \
    const bool msk_ = (d_ == 1) || tau_ == 0 || tau_ == 4 || (utop - d_ * (32 * tau_ + 31) < 0); \
    f32x16 sa_; attn_tile_a(msk_, d_, KCUR_, qf, sa_, mrow, D0_, lim_, nsl); \
    attn_issue_k(kbase, utop, tix_ + 2, n, KNXT_); attn_issue_v(vbase, utop, tix_ + 3, lane, vring); \
    attn_tile_b(tix_ == 0, sa_, o0, o1, mrow, lrow, ta0 + (unsigned)((tix_ & 3) * 4096), ta1 + (unsigned)((tix_ & 3) * 4096)); }
DI void attn_phase(const Params& p, LAS unsigned char* lds) {
    const int tid = threadIdx.x, wid = __builtin_amdgcn_readfirstlane(tid >> 6), lane = tid & 63, n = lane & 31, h = lane >> 5, g = n >> 3, iq = n & 7;
    LAS unsigned char* vring = lds + wid * 16384;
    const unsigned vb = (unsigned)(uintptr_t)vring;
    unsigned ta0, ta1;
    { const int i16 = lane & 15, q = i16 >> 2, pp = i16 & 3, blk = (lane >> 4) & 1, sw = (q >> 1) & 1;
      const unsigned rowoff = (unsigned)(4 * h + q) * 128u + 8u * (pp & 1);
      ta0 = vb + rowoff + (unsigned)(((2 * blk + (pp >> 1)) ^ (sw << 2)) * 16);
      ta1 = vb + rowoff + (unsigned)(((4 + 2 * blk + (pp >> 1)) ^ (sw << 2)) * 16); }
    for (int gidx = blockIdx.x; gidx < 1024; gidx += gridDim.x) {
        const int xx = gidx & 7, cj = (gidx >> 3) & 31, it = gidx >> 8, pair = xx + 8 * it, b = pair >> 2, kvh = pair & 3, T0 = cj * 128;
        const bf16_t* projb = p.PROJ + (size_t)b * SEQ * INC;
        const char* kbase = (const char*)(projb + COL_K + kvh * 64 + 8 * h);
        const char* vbase = (const char*)(projb + COL_V + kvh * 64 + 8 * ((lane & 7) ^ (((lane >> 4) & 1) << 2)));
        for (int rr = 0; rr < 2; ++rr) {
            const int r = wid + 8 * rr, tq = T0 + r + 16 * iq, utop = T0 + r + 112, head = kvh * 4 + g, dq = -16 * (7 - iq);
            const float nsl = -fexp2(-0.5f * (float)(head + 1)) * LOG2E;
            bf16x8 qf[4];
            { const bf16_t* qp = projb + (size_t)tq * INC + head * 64 + 8 * h;
#pragma unroll
              for (int s = 0; s < 4; ++s) qf[s] = *(const bf16x8*)(qp + 16 * s); }
            f32x16 o0, o1;
#pragma unroll
            for (int i = 0; i < 16; ++i) { o0[i] = 0.f; o1[i] = 0.f; }
            float mrow = 0.f, lrow = 0.f;
            bf16x8 kA[4], kB[4], kC[4];
            asm volatile("s_waitcnt vmcnt(0)" ::: "memory");
            attn_issue_v(vbase, utop, 0, lane, vring); attn_issue_v(vbase, utop, 1, lane, vring); attn_issue_v(vbase, utop, 2, lane, vring);
            attn_issue_k(kbase, utop, 0, n, kA); attn_issue_k(kbase, utop, 1, n, kB);
            asm volatile("" ::: "memory");
            for (int tix = 0; tix < 18; tix += 3) { ATT_STEP(tix, kA, kC) ATT_STEP(tix + 1, kB, kA) ATT_STEP(tix + 2, kC, kB) }
            const float inv = 1.0f / lrow;
            const bf16_t* gp = projb + (size_t)tq * INC + COL_AG + head * 64 + 4 * h;
            bf16_t* yp = p.Y + ((size_t)b * SEQ + tq) * MIXW + head * 64 + 4 * h;
#pragma unroll
            for (int ct = 0; ct < 2; ++ct)
#pragma unroll
                for (int gq = 0; gq < 4; ++gq) { const u32x2 gw = *(const u32x2*)(gp + 32 * ct + 8 * gq);
                    const float a0 = (ct ? o1[4 * gq] : o0[4 * gq]) * inv * bf_lo(gw.x), a1 = (ct ? o1[4 * gq + 1] : o0[4 * gq + 1]) * inv * bf_hi(gw.x);
                    const float a2 = (ct ? o1[4 * gq + 2] : o0[4 * gq + 2]) * inv * bf_lo(gw.y), a3 = (ct ? o1[4 * gq + 3] : o0[4 * gq + 3]) * inv * bf_hi(gw.y);
                    u32x2 ow; ow.x = pk_bf16(a0, a1); ow.y = pk_bf16(a2, a3);
                    *(u32x2*)(yp + 32 * ct + 8 * gq) = ow; }
            asm volatile("s_waitcnt vmcnt(0)" ::: "memory");
        }
    }
}

#define CONV_BFLY(V, N, MASK) { _Pragma("unroll") for (int i_ = 0; i_ < (N); ++i_) { const bool up_ = (lane & (MASK)) != 0; const float keep_ = up_ ? V[i_ + (N)] : V[i_]; const float send_ = up_ ? V[i_] : V[i_ + (N)]; V[i_] = keep_ + __shfl_xor(send_, (MASK)); } }
DI void conv_phase(const Params& p, LAS unsigned char* lds) {
    const int tid = threadIdx.x, wid = tid >> 6, lane = tid & 63, ch = tid * 2;
    f32x2v w[31];
#pragma unroll
    for (int k = 0; k < 31; ++k) w[k] = *(const f32x2v*)(p.conv_w + k * DM + ch);
    const f32x2v cb = *(const f32x2v*)(p.conv_b + ch), lg = *(const f32x2v*)(p.ln_g + ch), lb = *(const f32x2v*)(p.ln_b + ch);
    LAS float* part = (LAS float*)lds;
    LAS float* stats = part + 512;
    for (int tile_ = blockIdx.x; tile_ < (NTOK / 32) * p.rep_conv; tile_ += gridDim.x) {
        const int tile = tile_ & (NTOK / 32 - 1);
        const int tok0 = tile * 32, b = tok0 / SEQ, s0 = tok0 % SEQ;
        const bf16_t* projb = p.PROJ + (size_t)b * SEQ * INC;
        f32x2v acc[32];
#pragma unroll
        for (int t = 0; t < 32; ++t) acc[t] = cb;
#pragma clang loop unroll(full)
        for (int js = 0; js < 62; ++js) {
            const int s = s0 - 30 + js;
            f32x2v xin = {0.f, 0.f};
            if (s >= 0) { const bf16_t* pr = projb + (size_t)s * INC + ch; const unsigned vv = *(const unsigned*)(pr + COL_CV), gg = *(const unsigned*)(pr + COL_CG);
                xin[0] = bf_lo(vv) * bf_lo(gg); xin[1] = bf_hi(vv) * bf_hi(gg); }
#pragma clang loop unroll(full)
            for (int t = 0; t < 32; ++t) { const int k = js - t; if (k >= 0 && k <= 30) acc[t] += w[k] * xin; }
        }
        float v1[32], v2[32];
#pragma unroll
        for (int t = 0; t < 32; ++t) { v1[t] = acc[t][0] + acc[t][1]; v2[t] = acc[t][0] * acc[t][0] + acc[t][1] * acc[t][1]; }
        CONV_BFLY(v1, 16, 32) CONV_BFLY(v1, 8, 16) CONV_BFLY(v1, 4, 8) CONV_BFLY(v1, 2, 4) CONV_BFLY(v1, 1, 2)
        CONV_BFLY(v2, 16, 32) CONV_BFLY(v2, 8, 16) CONV_BFLY(v2, 4, 8) CONV_BFLY(v2, 2, 4) CONV_BFLY(v2, 1, 2)
        v1[0] += __shfl_xor(v1[0], 1); v2[0] += __shfl_xor(v2[0], 1);
        if ((lane & 1) == 0) { part[(wid * 32 + (lane >> 1)) * 2] = v1[0]; part[(wid * 32 + (lane >> 1)) * 2 + 1] = v2[0]; }
        __syncthreads();
        if (tid < 32) { float a = 0.f, q = 0.f;
#pragma unroll
            for (int wv = 0; wv < 8; ++wv) { a += part[(wv * 32 + tid) * 2]; q += part[(wv * 32 + tid) * 2 + 1]; }
            const float mean = a * (1.0f / DM), var = q * (1.0f / DM) - mean * mean;
            stats[tid * 2] = mean; stats[tid * 2 + 1] = rsqrtf(fmaxf(var, 0.f) + 1e-5f); }
        __syncthreads();
#pragma unroll
        for (int t = 0; t < 32; ++t) { const float mean = stats[t * 2], rstd = stats[t * 2 + 1];
            const unsigned gw = *(const unsigned*)(projb + (size_t)(s0 + t) * INC + COL_CGATE + ch);
            const float y0 = silu((acc[t][0] - mean) * rstd * lg[0] + lb[0]) * bf_lo(gw), y1 = silu((acc[t][1] - mean) * rstd * lg[1] + lb[1]) * bf_hi(gw);
            *(unsigned*)(p.Y + ((size_t)tok0 + t) * MIXW + DM + ch) = pk_bf16(y0, y1); }
    }
}

DI void final_phase(const Params& p) {
    const int tid = threadIdx.x, wid = tid >> 6, lane = tid & 63;
    for (int row = blockIdx.x * 8 + wid; row < NTOK; row += gridDim.x * 8) {
        float part = lane < 16 ? p.rowss[(size_t)row * 16 + lane] : 0.f;
        part = wave_sum(part);
        const float rstd = rsqrtf(part * (1.0f / DM) + 1e-6f);
        float* orow = p.out + (size_t)row * DM;
#pragma unroll
        for (int j = 0; j < 2; ++j) { const int c = j * 512 + lane * 8;
            const f32x4 a = *(const f32x4*)(orow + c), b = *(const f32x4*)(orow + c + 4), g0 = *(const f32x4*)(p.fin_g + c), g1 = *(const f32x4*)(p.fin_g + c + 4);
            *(f32x4*)(orow + c) = a * rstd * g0; *(f32x4*)(orow + c + 4) = b * rstd * g1; }
    }
}

template <int PH> __global__ void __launch_bounds__(512, 2) fwd_kernel(Params p) {
    extern __shared__ __attribute__((aligned(16))) unsigned char shm[];
    LAS unsigned char* lds = (LAS unsigned char*)shm;
    __shared__ uint4 xb_words;
    XcdBarrier xb;
    if constexpr (PH == 31) { if (threadIdx.x == 0) xb_words = make_uint4(0u, 0u, 0u, 0u); __syncthreads(); xb = xcd_barrier_post(p.bar, (volatile LAS unsigned*)&xb_words); }
    if constexpr (PH & 1) prep_phase(p, lds);
    if constexpr ((PH & 1) && (PH & 2)) cg::this_grid().sync();
    if constexpr (PH & 2) { pg8::Gemm g{p.H, p.WinT, NTOK, INC, DM}; pg8::StaticOrder S; S.init(NTOK, INC, (int)gridDim.x, (int)blockIdx.x); EpiProj E{p.PROJ};
        pg8::gemm_phase<EpiProj, pg8::StaticOrder, false>(lds, g, S, E, nullptr); }
    if constexpr ((PH & 2) && (PH & 4)) xcd_barrier(xb);
    if constexpr (PH & 4) {
#ifndef NO_ATTN
        attn_phase(p, lds); __syncthreads();
#endif
#ifndef NO_CONV
        conv_phase(p, lds);
#endif
    }
    if constexpr ((PH & 4) && (PH & 8)) xcd_barrier(xb);
    if constexpr (PH & 8) { __syncthreads(); pg8::Gemm g{p.Y, p.WoutT, NTOK, DM, MIXW}; pg8::StaticOrder S; S.init(NTOK, DM, (int)gridDim.x, (int)blockIdx.x); EpiOut E{p.x, p.out, p.rowss};
        pg8::gemm_phase<EpiOut, pg8::StaticOrder, false>(lds, g, S, E, nullptr); }
    if constexpr ((PH & 8) && (PH & 16)) xcd_barrier(xb);
    if constexpr (PH == 31) { for (int rep = 0; rep < p.rep_sync; ++rep) xcd_barrier(xb); }
    if constexpr (PH & 16) final_phase(p);
}

#ifndef N_LAUNCH_MODE
#define N_LAUNCH_MODE 1
#endif
extern "C" void kernel_launch(void* const* d_in, const int* in_sizes, int n_in, void* d_out, int out_size, void* d_ws, size_t ws_size, hipStream_t stream) {
    (void)in_sizes; (void)n_in; (void)out_size;
    Params p{};
    p.x = (const float*)d_in[0]; p.norm_g = (const float*)d_in[1]; p.w_in = (const float*)d_in[2]; p.conv_w = (const float*)d_in[3]; p.conv_b = (const float*)d_in[4];
    p.ln_g = (const float*)d_in[5]; p.ln_b = (const float*)d_in[6]; p.w_out = (const float*)d_in[7]; p.fin_g = (const float*)d_in[8];
    p.out = (float*)d_out;
    p.H = (bf16_t*)d_out;
    char* ws = (char*)d_ws; size_t off = 0;
    p.PROJ = (bf16_t*)(ws + off); off += (size_t)NTOK * INC * 2;
    p.Y = (bf16_t*)(ws + off); off += (size_t)NTOK * MIXW * 2;
    p.WinT = (bf16_t*)(ws + off); off += (size_t)INC * DM * 2;
    p.WoutT = (bf16_t*)(ws + off); off += (size_t)DM * MIXW * 2;
    p.rowss = (float*)(ws + off); off += (size_t)NTOK * 16 * 4;
    p.bar = (unsigned*)(ws + off); off += (size_t)XCD_BAR_WORDS * 4;
#ifdef REP_CONV
    p.rep_conv = REP_CONV;
#else
    p.rep_conv = 1;
#endif
#ifdef REP_SYNC
    p.rep_sync = REP_SYNC;
#else
    p.rep_sync = 0;
#endif
    if (off > ws_size) { fprintf(stderr, "kernel_launch: workspace too small (%zu needed, %zu given)\n", off, ws_size); return; }
    static int grid = 0;
    if (!grid) {
        int dev = 0, cus = 0, per_cu = 0; hipGetDevice(&dev); hipDeviceGetAttribute(&cus, hipDeviceAttributeMultiprocessorCount, dev);
        hipFuncSetAttribute((const void*)fwd_kernel<31>, hipFuncAttributeMaxDynamicSharedMemorySize, LDS_BYTES);
        hipFuncSetAttribute((const void*)fwd_kernel<1>, hipFuncAttributeMaxDynamicSharedMemorySize, LDS_BYTES);
        hipFuncSetAttribute((const void*)fwd_kernel<2>, hipFuncAttributeMaxDynamicSharedMemorySize, LDS_BYTES);
        hipFuncSetAttribute((const void*)fwd_kernel<4>, hipFuncAttributeMaxDynamicSharedMemorySize, LDS_BYTES);
        hipFuncSetAttribute((const void*)fwd_kernel<8>, hipFuncAttributeMaxDynamicSharedMemorySize, LDS_BYTES);
        hipFuncSetAttribute((const void*)fwd_kernel<16>, hipFuncAttributeMaxDynamicSharedMemorySize, LDS_BYTES);
        hipOccupancyMaxActiveBlocksPerMultiprocessor(&per_cu, (const void*)fwd_kernel<31>, 512, LDS_BYTES);
        if (per_cu < 1) { fprintf(stderr, "kernel_launch: occupancy query says 0 blocks/CU\n"); per_cu = 1; }
        grid = cus * per_cu;
    }
#if N_LAUNCH_MODE == 1
    hipMemsetAsync(p.bar, 0, (size_t)XCD_BAR_WORDS * 4, stream);
    void* args[] = {&p};
    hipError_t e = hipLaunchCooperativeKernel((const void*)fwd_kernel<31>, dim3(grid), dim3(512), args, LDS_BYTES, stream);
    if (e != hipSuccess) fprintf(stderr, "cooperative launch failed: %s (grid %d)\n", hipGetErrorString(e), grid);
#else
    hipLaunchKernelGGL(fwd_kernel<1>, dim3(grid), dim3(512), LDS_BYTES, stream, p);
    hipLaunchKernelGGL(fwd_kernel<2>, dim3(grid), dim3(512), LDS_BYTES, stream, p);
    hipLaunchKernelGGL(fwd_kernel<4>, dim3(grid), dim3(512), LDS_BYTES, stream, p);
    hipLaunchKernelGGL(fwd_kernel<8>, dim3(grid), dim3(512), LDS_BYTES, stream, p);
    hipLaunchKernelGGL(fwd_kernel<16>, dim3(grid), dim3(512), LDS_BYTES, stream, p);
#endif
}
```

```cpp
#include <hip/hip_runtime.h>
#include <hip/hip_cooperative_groups.h>
#include <cstdio>
#include <cstdint>
namespace cg = cooperative_groups;
#define XB_TMO      128
#define XB_XCNT(j)  (256  + 64 * (j))
#define XB_XSUB(j)  (1280 + 64 * (j))
#define XB_XGEN(j)  (2304 + 64 * (j))
#define XB_TOP      3328
#define XB_TOPGEN   3392
#define XCD_BAR_WORDS 3456
#define XB_SPIN_CAP (1u << 18)
#define LAS __attribute__((address_space(3)))

__device__ __forceinline__ unsigned xb_ld(unsigned* p)              { return __hip_atomic_load(p, __ATOMIC_RELAXED, __HIP_MEMORY_SCOPE_AGENT); }
__device__ __forceinline__ unsigned xb_add(unsigned* p, unsigned v) { return __hip_atomic_fetch_add(p, v, __ATOMIC_RELAXED, __HIP_MEMORY_SCOPE_AGENT); }
__device__ __forceinline__ unsigned xb_xcc_id() { return (unsigned)__builtin_amdgcn_s_getreg((3 << 11) | 20) & 0xFu; }
#define XB_SPIN(cond, bar) do { unsigned _sp = 0; while (cond) { __builtin_amdgcn_s_sleep(1); \
    if ((++_sp & 255u) == 0u) { if (xb_ld(&(bar)[XB_TMO])) break; if (_sp > XB_SPIN_CAP) { atomicAdd(&(bar)[XB_TMO], 1u); break; } } } } while (0)

struct XcdBarrier {
    unsigned* bar; unsigned x;
    volatile LAS unsigned* st;
};

__device__ __forceinline__ XcdBarrier xcd_barrier_post(unsigned* bar, volatile LAS unsigned* st) {
    XcdBarrier b; b.bar = bar; b.x = xb_xcc_id(); b.st = st;
    if (threadIdx.x == 0) (void)xb_add(&bar[XB_XCNT(b.x)], 1u);
    return b;
}
__device__ __forceinline__ void xcd_barrier_complete(unsigned* bar, unsigned x, unsigned& nloc, unsigned& nx) {
    const unsigned G = gridDim.x * gridDim.y * gridDim.z;
    unsigned sum, cnt, mine, sp = 0u;
    for (;;) {
        sum = 0u; cnt = 0u; mine = 0u;
#pragma unroll
        for (unsigned j = 0; j < 16; ++j) { const unsigned c = xb_ld(&bar[XB_XCNT(j)]); sum += c; cnt += (c > 0u) ? 1u : 0u; mine = (j == x) ? c : mine; }
        if (sum == G) break;
        __builtin_amdgcn_s_sleep(1);
        if ((++sp & 255u) == 0u) { if (xb_ld(&bar[XB_TMO])) break; if (sp > XB_SPIN_CAP) { atomicAdd(&bar[XB_TMO], 1u); break; } }
    }
    nloc = mine > 0u ? mine : 1u; nx = cnt > 0u ? cnt : 1u;
}

__device__ __forceinline__ void xcd_barrier(const XcdBarrier& b) {
    asm volatile("s_waitcnt vmcnt(0)" ::: "memory");
    __syncthreads();
    if (threadIdx.x == 0) {
        unsigned* bar = b.bar;
        __builtin_amdgcn_s_waitcnt(0);
        unsigned nloc = b.st[0], nx = b.st[1];
        if (nloc == 0u) { xcd_barrier_complete(bar, b.x, nloc, nx); b.st[0] = nloc; b.st[1] = nx; }
        const unsigned old = xb_add(&bar[XB_XSUB(b.x)], 1u);
        const unsigned gen = old / nloc;
        if (old + 1u == (gen + 1u) * nloc) {
            __builtin_amdgcn_fence(__ATOMIC_RELEASE, "agent");
            asm volatile("s_waitcnt vmcnt(0)" ::: "memory");
            const unsigned og = xb_add(&bar[XB_TOP], 1u);
            const unsigned tg = og / nx;
            if (og + 1u == (tg + 1u) * nx) xb_add(&bar[XB_TOPGEN], 1u);
            else XB_SPIN(xb_ld(&bar[XB_TOPGEN]) == tg, bar);
            __builtin_amdgcn_fence(__ATOMIC_ACQUIRE, "agent");
            xb_add(&bar[XB_XGEN(b.x)], 1u);
            asm volatile("s_waitcnt vmcnt(0)" ::: "memory");
        } else {
            XB_SPIN(xb_ld(&bar[XB_XGEN(b.x)]) == gen, bar);
            __builtin_amdgcn_fence(__ATOMIC_ACQUIRE, "agent");
            asm volatile("s_waitcnt vmcnt(0)" ::: "memory");
        }
    }
    __syncthreads();
}
namespace pg8 {
#define PG8_LAS __attribute__((address_space(3)))
typedef unsigned short bf16_t;
typedef short bf16x8 __attribute__((ext_vector_type(8)));
typedef float f32x4 __attribute__((ext_vector_type(4)));
typedef unsigned u32x4 __attribute__((ext_vector_type(4)));
constexpr int BM = 256, BK = 64, HALF = 128, HTB = HALF * BK * 2  , STAGE_BYTES = 8 * HTB, NXCD = 8, WGM = 8;

__host__ __device__ __forceinline__ int lds_byte(int r, int c) { const int st = (r >> 4) * 2 + (c >> 5), rr = r & 15, cc = c & 31, ob = rr * 64 + cc * 2; return st * 1024 + (ob ^ (((ob >> 9) & 1) << 5)); }
__host__ __device__ __forceinline__ void stage_rc(int b, int& R, int& C) { const int st = b / 1024, sb = b % 1024, swz = sb ^ (((sb >> 9) & 1) << 5); R = (st >> 1) * 16 + swz / 64; C = (st & 1) * 32 + (swz % 64) / 2; }
__host__ __device__ __forceinline__ int perm32(int rho) { const int n = rho >> 4, i = rho & 15; return 8 * (i >> 2) + 4 * n + (i & 3); }

struct Unit { int pm, pn; };
struct Gemm { const bf16_t* A; const bf16_t* Bt; int M, N, K; };

struct StaticOrder {
    int nM, nN, nwg, G, c;
    __host__ __device__ void init(int M, int N, int G_, int c_) { nM = M / BM; nN = N / BM; nwg = nM * nN; G = G_; c = c_; }
    __host__ __device__ bool next(int i, Unit& u) const {
        const long L = (long)i * G + c; if (L >= nwg) return false;
        int wgid = (int)L; { const int q = nwg / NXCD, r = nwg % NXCD, xcd = wgid % NXCD, off = wgid / NXCD; wgid = (xcd < r ? xcd * (q + 1) : r * (q + 1) + (xcd - r) * q) + off; }
        const int nig = WGM * nN, gid = wgid / nig, fm = gid * WGM, gsz = (nM - fm) < WGM ? (nM - fm) : WGM;
        u.pm = fm + ((wgid % nig) % gsz); u.pn = (wgid % nig) / gsz; return true;
    }
    __device__ __forceinline__ void a_ready(const Unit&) const {}
    __device__ __forceinline__ void done(const Unit&) const {}
};
__device__ __forceinline__ unsigned cvt_pk_bf16(float lo, float hi) { unsigned r; asm volatile("v_cvt_pk_bf16_f32 %0, %1, %2" : "=v"(r) : "v"(lo), "v"(hi)); return r; }
typedef float f32x2 __attribute__((ext_vector_type(2)));
template <class Epi, class Sched, bool STAMP = false>
__device__ __forceinline__ void gemm_phase(PG8_LAS unsigned char* lds, const Gemm g, const Sched& S, const Epi& E, unsigned long long* stamps) {
    const int tid = threadIdx.x, wid = __builtin_amdgcn_readfirstlane(tid >> 6), lane = tid & 63, wr = wid >> 2, wc = wid & 3, fr = lane & 15, fq = lane >> 4;
    const int K = g.K, nt = K / BK;
    int ts_lo = 0, ts_hi = 0, nts = 0; const unsigned long long rt_entry = STAMP ? (unsigned long long)wall_clock64() : 0ull;
#define PG8_STAMP() do { if (STAMP && wid == 0 && nts < 64) { const unsigned long long _c = (unsigned long long)clock64(); \
        ts_lo = (lane == nts) ? (int)(unsigned)_c : ts_lo; ts_hi = (lane == nts) ? (int)(unsigned)(_c >> 32) : ts_hi; ++nts; } } while (0)
    PG8_STAMP();
    unsigned voffA[2], voffB[2];
#pragma unroll
    for (int i = 0; i < 2; ++i) { int R, C; stage_rc(tid * 16 + i * 8192, R, C); const int Rb = Epi::PERM ? ((R & ~31) + perm32(R & 31)) : R;
        voffA[i] = (unsigned)(R * K + C) * 2u; voffB[i] = (unsigned)(Rb * K + C) * 2u; }
    const size_t kstep = (size_t)(BK * 2);
    const size_t hstep = (size_t)HALF * K * 2;
    const size_t tstep = 2 * hstep;
    const unsigned ldsw = (unsigned)wid * 1024u;
    const int aoff = lds_byte(wr * 64 + fr, fq * 8), boff = lds_byte(wc * 32 + fr, fq * 8);
#define PG8_SA(b, h) (((b) * 2 + (h)) * HTB)
#define PG8_SB(b, h) ((4 + (b) * 2 + (h)) * HTB)
#define PG8_STAGE(bufoff, gbase, voff) do { _Pragma("unroll") for (int _i = 0; _i < 2; ++_i) \
        __builtin_amdgcn_global_load_lds((const unsigned*)((const char*)(gbase) + (voff)[_i]), (PG8_LAS unsigned*)(lds + (bufoff) + ldsw + _i * 8192), 16, 0, 0); } while (0)
#define PG8_LDA(dst, b, h) do { _Pragma("unroll") for (int m = 0; m < 4; ++m) _Pragma("unroll") for (int k = 0; k < 2; ++k) dst[m][k] = *(const PG8_LAS bf16x8*)(lds + PG8_SA(b, h) + aoff + m * 2048 + k * 1024); } while (0)
#define PG8_LDB(dst, b, h) do { _Pragma("unroll") for (int n = 0; n < 2; ++n) _Pragma("unroll") for (int k = 0; k < 2; ++k) dst[n][k] = *(const PG8_LAS bf16x8*)(lds + PG8_SB(b, h) + boff + n * 2048 + k * 1024); } while (0)
#define PG8_MMA(ai, bj, At, Bt) do { __builtin_amdgcn_s_setprio(1); _Pragma("unroll") for (int m = 0; m < 4; ++m) _Pragma("unroll") for (int n = 0; n < 2; ++n) _Pragma("unroll") for (int k = 0; k < 2; ++k) \
        acc[ai][bj][m][n] = __builtin_amdgcn_mfma_f32_16x16x32_bf16(Bt[n][k], At[m][k], acc[ai][bj][m][n], 0, 0, 0); __builtin_amdgcn_s_setprio(0); } while (0)
#define PG8_WAIT_V(n) asm volatile("s_waitcnt vmcnt(" #n ")" ::: "memory")
#define PG8_WAIT_L(n) asm volatile("s_waitcnt lgkmcnt(" #n ")" ::: "memory")
#define PG8_BAR __builtin_amdgcn_s_barrier()
#define PG8_SCHED __builtin_amdgcn_sched_barrier(0)
    Unit cur, nxt; int ui = 0;
    if (!S.next(0, cur)) return;
    f32x4 acc[2][2][4][2];
#pragma unroll
    for (int a = 0; a < 2; ++a)
#pragma unroll
        for (int b = 0; b < 2; ++b)
#pragma unroll
            for (int m = 0; m < 4; ++m)
#pragma unroll
                for (int n = 0; n < 2; ++n) acc[a][b][m][n] = (f32x4){0.f, 0.f, 0.f, 0.f};
    bf16x8 At[4][2], B0[2][2], B1[2][2];
    const char* cA = (const char*)g.A + (size_t)cur.pm * tstep; const char* cB = (const char*)g.Bt + (size_t)cur.pn * tstep;
    S.a_ready(cur);
    PG8_STAGE(PG8_SB(0, 0), cB, voffB); PG8_STAGE(PG8_SA(0, 0), cA, voffA); PG8_STAGE(PG8_SB(0, 1), cB + hstep, voffB); PG8_STAGE(PG8_SA(0, 1), cA + hstep, voffA);
    if (wr == 1) PG8_BAR;
    PG8_WAIT_V(4); PG8_BAR;
    PG8_STAGE(PG8_SB(1, 0), cB + kstep, voffB); PG8_STAGE(PG8_SA(1, 0), cA + kstep, voffA); PG8_STAGE(PG8_SB(1, 1), cB + hstep + kstep, voffB);
    PG8_WAIT_V(6); PG8_BAR;
    PG8_STAMP();
    for (;;) {
        const bool has_next = S.next(ui + 1, nxt);
        const char* nA = has_next ? (const char*)g.A + (size_t)nxt.pm * tstep : cA; const char* nB = has_next ? (const char*)g.Bt + (size_t)nxt.pn * tstep : cB;
        for (int t = 0; t < nt; t += 2) {
            const bool last = (t == nt - 2);
            const char* a1 = cA + (size_t)(t + 1) * kstep;
            const char* a2 = last ? nA : cA + (size_t)(t + 2) * kstep; const char* b2 = last ? nB : cB + (size_t)(t + 2) * kstep;
            const char* a3 = a2 + kstep; const char* b3 = b2 + kstep;
            if (last && has_next) S.a_ready(nxt);
            PG8_LDB(B0, 0, 0); PG8_SCHED; PG8_LDA(At, 0, 0); PG8_STAGE(PG8_SA(1, 1), a1 + hstep, voffA);
            PG8_WAIT_L(8); PG8_BAR; PG8_WAIT_L(0); PG8_MMA(0, 0, At, B0); PG8_BAR; PG8_SCHED;
            PG8_LDB(B1, 0, 1); PG8_STAGE(PG8_SB(0, 0), b2, voffB);
            PG8_BAR; PG8_WAIT_L(0); PG8_MMA(0, 1, At, B1); PG8_BAR;
            PG8_LDA(At, 0, 1); PG8_STAGE(PG8_SA(0, 0), a2, voffA);
            PG8_BAR; PG8_WAIT_L(0); PG8_MMA(1, 0, At, B0); PG8_BAR; PG8_SCHED;
            PG8_STAGE(PG8_SB(0, 1), b2 + hstep, voffB);
            PG8_WAIT_V(6); PG8_BAR; PG8_MMA(1, 1, At, B1); PG8_BAR;
            PG8_LDB(B0, 1, 0); PG8_SCHED; PG8_LDA(At, 1, 0); PG8_STAGE(PG8_SA(0, 1), a2 + hstep, voffA);
            PG8_WAIT_L(8); PG8_BAR; PG8_WAIT_L(0); PG8_MMA(0, 0, At, B0); PG8_BAR; PG8_SCHED;
            PG8_LDB(B1, 1, 1); PG8_STAGE(PG8_SB(1, 0), b3, voffB);
            PG8_BAR; PG8_WAIT_L(0); PG8_MMA(0, 1, At, B1); PG8_BAR;
            PG8_LDA(At, 1, 1); PG8_STAGE(PG8_SA(1, 0), a3, voffA);
            PG8_BAR; PG8_WAIT_L(0); PG8_MMA(1, 0, At, B0); PG8_BAR; PG8_SCHED;
            PG8_STAGE(PG8_SB(1, 1), b3 + hstep, voffB);
            PG8_WAIT_V(6); PG8_BAR; PG8_MMA(1, 1, At, B1); PG8_BAR;
        }
        PG8_STAMP();
        if constexpr (!Epi::AFTER_DRAIN) { E(acc, cur, wr, wc, fr, fq); S.done(cur); }
        PG8_STAMP();
        if (!has_next) break;
#pragma unroll
        for (int a = 0; a < 2; ++a)
#pragma unroll
            for (int b = 0; b < 2; ++b)
#pragma unroll
                for (int m = 0; m < 4; ++m)
#pragma unroll
                    for (int n = 0; n < 2; ++n) acc[a][b][m][n] = (f32x4){0.f, 0.f, 0.f, 0.f};
        cur = nxt; cA = nA; cB = nB; ++ui;
    }
    PG8_WAIT_V(0);
    if (wr == 0) PG8_BAR;
    PG8_BAR;
    if constexpr (Epi::AFTER_DRAIN) { E.fused(acc, cur, wr, wc, fr, fq, lds, wid, lane); S.done(cur); }
    PG8_STAMP();
    if (STAMP && wid == 0) { stamps[lane] = lane < nts ? (((unsigned long long)(unsigned)ts_hi << 32) | (unsigned)ts_lo) : 0ull;
        if (lane == 62) stamps[62] = rt_entry; if (lane == 63) stamps[63] = (unsigned long long)wall_clock64(); }
#undef PG8_STAMP
#undef PG8_SA
#undef PG8_SB
#undef PG8_STAGE
#undef PG8_LDA
#undef PG8_LDB
#undef PG8_MMA
#undef PG8_WAIT_V
#undef PG8_WAIT_L
#undef PG8_BAR
#undef PG8_SCHED
}
}
using pg8::bf16_t; using pg8::bf16x8; using pg8::f32x4; using pg8::u32x4;
typedef float f32x16 __attribute__((ext_vector_type(16)));
typedef short s16x4 __attribute__((ext_vector_type(4)));
typedef float f32x2v __attribute__((ext_vector_type(2)));
typedef unsigned u32x2 __attribute__((ext_vector_type(2)));
typedef __bf16 bf2_t __attribute__((ext_vector_type(2)));
#define DI __device__ __forceinline__

constexpr int BATCH = 8, SEQ = 4096, DM = 1024, NTOK = BATCH * SEQ, INC = 5632, MIXW = 2048;
constexpr int COL_K = 1024, COL_V = 1280, COL_AG = 1536, COL_CV = 2560, COL_CG = 3584, COL_CGATE = 4608;
constexpr float LOG2E = 1.4426950408889634f;
constexpr float QSCALE = 0.125f * LOG2E;
constexpr int LDS_BYTES = 131072;

struct Params {
    const float* x; const float* norm_g; const float* w_in; const float* conv_w; const float* conv_b; const float* ln_g; const float* ln_b; const float* w_out; const float* fin_g;
    float* out; bf16_t* H; bf16_t* WinT; bf16_t* WoutT; bf16_t* PROJ; bf16_t* Y; float* rowss;
    unsigned* bar; int rep_conv, rep_sync;
};

DI float fexp2(float x) { return __builtin_amdgcn_exp2f(x); }
DI float frcp(float x) { return __builtin_amdgcn_rcpf(x); }
DI float sigm(float x) { return frcp(1.0f + fexp2(-x * LOG2E)); }
DI float silu(float x) { return x * sigm(x); }
DI unsigned pk_bf16(float a, float b) { f32x2v v = {a, b}; bf2_t r = __builtin_convertvector(v, bf2_t); return __builtin_bit_cast(unsigned, r); }
DI float bf_lo(unsigned w) { return __uint_as_float(w << 16); }
DI float bf_hi(unsigned w) { return __uint_as_float(w & 0xffff0000u); }
DI float wave_sum(float v) { for (int o = 32; o >= 1; o >>= 1) v += __shfl_xor(v, o); return v; }

struct EpiProj {
    static constexpr bool PERM = true, AFTER_DRAIN = false;
    bf16_t* O;
    __device__ __forceinline__ void operator()(const f32x4 (&acc)[2][2][4][2], const pg8::Unit& u, int wr, int wc, int fr, int fq) const {
        const int row0 = u.pm * 256 + wr * 64 + fr, pn = u.pn;
        if (pn >= 10 && pn < 18) {
            const int col0 = COL_CV + 128 * (pn - 10) + wc * 32 + 8 * fq;
#pragma unroll
            for (int ai = 0; ai < 2; ++ai)
#pragma unroll
                for (int m = 0; m < 4; ++m) { float v[8];
#pragma unroll
                    for (int j = 0; j < 4; ++j) { v[j] = acc[ai][0][m][0][j] * sigm(acc[ai][1][m][0][j]); v[4 + j] = acc[ai][0][m][1][j] * sigm(acc[ai][1][m][1][j]); }
                    u32x4 w; w.x = pk_bf16(v[0], v[1]); w.y = pk_bf16(v[2], v[3]); w.z = pk_bf16(v[4], v[5]); w.w = pk_bf16(v[6], v[7]);
                    *(u32x4*)(O + (size_t)(row0 + ai * 128 + m * 16) * INC + col0) = w; }
            return;
        }
        const int col0 = pn * 256 + wc * 32 + 8 * fq;
        const int mode = pn < 4 ? 1 : pn < 6 ? 0 : 2;
#pragma unroll
        for (int ai = 0; ai < 2; ++ai)
#pragma unroll
            for (int m = 0; m < 4; ++m) { bf16_t* rowp = O + (size_t)(row0 + ai * 128 + m * 16) * INC + col0;
#pragma unroll
                for (int bj = 0; bj < 2; ++bj) { float v[8];
#pragma unroll
                    for (int j = 0; j < 4; ++j) { v[j] = acc[ai][bj][m][0][j]; v[4 + j] = acc[ai][bj][m][1][j]; }
                    if (mode == 1) {
#pragma unroll
                        for (int j = 0; j < 8; ++j) v[j] *= QSCALE;
                    } else if (mode == 2) {
#pragma unroll
                        for (int j = 0; j < 8; ++j) v[j] = silu(v[j]);
                    }
                    u32x4 w; w.x = pk_bf16(v[0], v[1]); w.y = pk_bf16(v[2], v[3]); w.z = pk_bf16(v[4], v[5]); w.w = pk_bf16(v[6], v[7]);
                    *(u32x4*)(rowp + bj * 128) = w; } }
    }
};
struct EpiOut {
    static constexpr bool PERM = false, AFTER_DRAIN = false;
    const float* X; float* out; float* rowss;
    __device__ __forceinline__ void operator()(const f32x4 (&acc)[2][2][4][2], const pg8::Unit& u, int wr, int wc, int fr, int fq) const {
        const int row0 = u.pm * 256 + wr * 64 + fr, col0 = u.pn * 256 + wc * 32 + 4 * fq;
#pragma unroll
        for (int ai = 0; ai < 2; ++ai)
#pragma unroll
            for (int m = 0; m < 4; ++m) { const int r = row0 + ai * 128 + m * 16; const size_t off = (size_t)r * DM + col0; float ss = 0.f;
#pragma unroll
                for (int bj = 0; bj < 2; ++bj)
#pragma unroll
                    for (int n = 0; n < 2; ++n) { const f32x4 xv = *(const f32x4*)(X + off + bj * 128 + n * 16); const f32x4 z = xv + acc[ai][bj][m][n];
                        *(f32x4*)(out + off + bj * 128 + n * 16) = z; ss += (z[0] * z[0] + z[1] * z[1]) + (z[2] * z[2] + z[3] * z[3]); }
                ss += __shfl_xor(ss, 16); ss += __shfl_xor(ss, 32);
                if (fq == 0) rowss[(size_t)r * 16 + u.pn * 4 + wc] = ss;
                asm volatile("" ::: "memory"); }
    }
};

DI void prep_phase(const Params& p, LAS unsigned char* lds) {
    const int tid = threadIdx.x, wid = tid >> 6, lane = tid & 63;
    for (int row0 = (blockIdx.x * 8 + wid) * 4; row0 < NTOK; row0 += gridDim.x * 32) {
        f32x4 v[4][4];
#pragma unroll
        for (int r = 0; r < 4; ++r) { const float* xr = p.x + (size_t)(row0 + r) * DM;
#pragma unroll
            for (int j = 0; j < 2; ++j) { v[r][2 * j] = *(const f32x4*)(xr + j * 512 + lane * 8); v[r][2 * j + 1] = *(const f32x4*)(xr + j * 512 + lane * 8 + 4); } }
#pragma unroll
        for (int r = 0; r < 4; ++r) { float ss = 0.f;
#pragma unroll
            for (int j = 0; j < 4; ++j) ss += (v[r][j][0] * v[r][j][0] + v[r][j][1] * v[r][j][1]) + (v[r][j][2] * v[r][j][2] + v[r][j][3] * v[r][j][3]);
            ss = wave_sum(ss);
            const float rstd = rsqrtf(ss * (1.0f / DM) + 1e-6f);
#pragma unroll
            for (int j = 0; j < 2; ++j) { const f32x4 g0 = *(const f32x4*)(p.norm_g + j * 512 + lane * 8), g1 = *(const f32x4*)(p.norm_g + j * 512 + lane * 8 + 4);
                const f32x4 a = v[r][2 * j] * rstd * g0, b = v[r][2 * j + 1] * rstd * g1;
                u32x4 w; w.x = pk_bf16(a[0], a[1]); w.y = pk_bf16(a[2], a[3]); w.z = pk_bf16(b[0], b[1]); w.w = pk_bf16(b[2], b[3]);
                *(u32x4*)(p.H + (size_t)(row0 + r) * DM + j * 512 + lane * 8) = w; } }
    }
    LAS float* tile = (LAS float*)lds;
    for (int t = blockIdx.x; t < 1408 + 512; t += gridDim.x) {
        const float* src; bf16_t* dst; int ldS, ldD;
        if (t < 1408) { const int kt = t / 88, nt = t % 88; int sc = nt * 64;
            if (sc >= COL_CV && sc < COL_CGATE) { const int tt = sc - COL_CV; sc = (((tt >> 7) & 1) ? COL_CG : COL_CV) + 128 * (tt >> 8) + (tt & 127); }
            src = p.w_in + (size_t)kt * 64 * INC + sc; ldS = INC; dst = p.WinT + (size_t)nt * 64 * DM + kt * 64; ldD = DM; }
        else { const int t2 = t - 1408, kt = t2 / 16, nt = t2 % 16; src = p.w_out + (size_t)kt * 64 * DM + nt * 64; ldS = DM; dst = p.WoutT + (size_t)nt * 64 * MIXW + kt * 64; ldD = MIXW; }
#pragma unroll
        for (int e = 0; e < 8; ++e) { const int idx = tid + 512 * e, k = idx >> 6, n = idx & 63; tile[k * 65 + n] = src[(size_t)k * ldS + n]; }
        __syncthreads();
        { const int n = tid >> 3, kc = (tid & 7) * 8; float f[8];
#pragma unroll
          for (int j = 0; j < 8; ++j) f[j] = tile[(kc + j) * 65 + n];
          u32x4 w; w.x = pk_bf16(f[0], f[1]); w.y = pk_bf16(f[2], f[3]); w.z = pk_bf16(f[4], f[5]); w.w = pk_bf16(f[6], f[7]);
          *(u32x4*)(dst + (size_t)n * ldD + kc) = w; }
        __syncthreads();
    }
}

DI void attn_issue_k(const char* kbase, int utop, int tix, int n, bf16x8 (&k)[4]) {
    tix = tix < 17 ? tix : 17;
    const int d = tix < 5 ? 16 : tix < 10 ? 4 : 1, tau = tix < 5 ? tix : tix < 10 ? tix - 5 : tix - 10;
    int uk = utop - d * (32 * tau + n); uk = uk < 0 ? 0 : uk;
    const char* kp = kbase + (size_t)__umul24((unsigned)uk, (unsigned)(INC * 2));
#pragma unroll
    for (int s = 0; s < 4; ++s) k[s] = *(const bf16x8*)(kp + 32 * s);
}
DI void attn_issue_v(const char* vbase, int utop, int tix, int lane, LAS unsigned char* vring) {
    tix = tix < 17 ? tix : 17;
    const int d = tix < 5 ? 16 : tix < 10 ? 4 : 1, tau = tix < 5 ? tix : tix < 10 ? tix - 5 : tix - 10;
    LAS unsigned char* dst = vring + (tix & 3) * 4096;
#pragma unroll
    for (int j = 0; j < 4; ++j) { int uv = utop - d * (32 * tau + 8 * j + (lane >> 3)); uv = uv < 0 ? 0 : uv;
        __builtin_amdgcn_global_load_lds((const unsigned*)(vbase + (size_t)__umul24((unsigned)uv, (unsigned)(INC * 2))), (LAS unsigned*)(dst + j * 1024), 16, 0, 0); }
}
constexpr float ATT_THR = 8.0f;
DI void attn_tile_a(const bool MASKED, const int D, const bf16x8 (&kf)[4], const bf16x8 (&qf)[4], f32x16& sa, const float mrow, int D0, int lim, float nsl) {
    const float A = nsl * (float)D0 - mrow, step = nsl * (float)D;
    { const f32x2v b01 = {A, A + step}; const f32x2v b23 = b01 + 2.f * step;
#pragma unroll
      for (int gq = 0; gq < 4; ++gq) { const f32x2v x = b01 + (8.f * gq) * step, y = b23 + (8.f * gq) * step; sa[4 * gq] = x[0]; sa[4 * gq + 1] = x[1]; sa[4 * gq + 2] = y[0]; sa[4 * gq + 3] = y[1]; } }
    if (MASKED) {
#pragma unroll
        for (int i = 0; i < 16; ++i) { const int ci = (i & 3) + 8 * (i >> 2); const bool valid = (unsigned)(D0 + D * ci) <= (unsigned)lim; sa[i] = valid ? sa[i] : -__builtin_inff(); }
    }
#pragma unroll
    for (int s = 0; s < 4; ++s) sa = __builtin_amdgcn_mfma_f32_32x32x16_bf16(kf[s], qf[s], sa, 0, 0, 0);
}
DI void attn_tile_b(const bool first, f32x16& sa, f32x16& o0, f32x16& o1, float& mrow, float& lrow, unsigned ta0, unsigned ta1) {
    float pmax = fmaxf(fmaxf(sa[0], sa[1]), sa[2]);
#pragma unroll
    for (int i = 3; i < 15; i += 2) pmax = fmaxf(fmaxf(pmax, sa[i]), sa[i + 1]);
    pmax = fmaxf(pmax, sa[15]);
    { auto rr = __builtin_amdgcn_permlane32_swap(__float_as_uint(pmax), __float_as_uint(pmax), false, false); pmax = fmaxf(__uint_as_float(rr[0]), __uint_as_float(rr[1])); }
    if (first || !__all(pmax <= ATT_THR)) {
        const float delta = first ? pmax : fmaxf(pmax, 0.f), alpha = first ? 1.f : fexp2(-delta);
#pragma unroll
        for (int i = 0; i < 16; ++i) { sa[i] -= delta; o0[i] *= alpha; o1[i] *= alpha; }
        lrow *= alpha; mrow += delta;
    }
    f32x2v rs2 = {0.f, 0.f};
#pragma unroll
    for (int i = 0; i < 16; i += 2) { sa[i] = fexp2(sa[i]); sa[i + 1] = fexp2(sa[i + 1]); const f32x2v pp = {sa[i], sa[i + 1]}; rs2 += pp; }
    float rs = rs2[0] + rs2[1];
    { auto rr = __builtin_amdgcn_permlane32_swap(__float_as_uint(rs), __float_as_uint(rs), false, false); rs = __uint_as_float(rr[0]) + __uint_as_float(rr[1]); }
    lrow += rs;
    u32x4 pw0, pw1;
    pw0.x = pk_bf16(sa[0], sa[1]); pw0.y = pk_bf16(sa[2], sa[3]); pw0.z = pk_bf16(sa[4], sa[5]); pw0.w = pk_bf16(sa[6], sa[7]);
    pw1.x = pk_bf16(sa[8], sa[9]); pw1.y = pk_bf16(sa[10], sa[11]); pw1.z = pk_bf16(sa[12], sa[13]); pw1.w = pk_bf16(sa[14], sa[15]);
    const bf16x8 pf0 = __builtin_bit_cast(bf16x8, pw0), pf1 = __builtin_bit_cast(bf16x8, pw1);
    s16x4 t0, t1, t2, t3, t4, t5, t6, t7;
    asm volatile("s_waitcnt vmcnt(24)\n\t"
                 "ds_read_b64_tr_b16 %0, %8\n\t"
                 "ds_read_b64_tr_b16 %1, %8 offset:1024\n\t"
                 "ds_read_b64_tr_b16 %2, %8 offset:2048\n\t"
                 "ds_read_b64_tr_b16 %3, %8 offset:3072\n\t"
                 "ds_read_b64_tr_b16 %4, %9\n\t"
                 "ds_read_b64_tr_b16 %5, %9 offset:1024\n\t"
                 "ds_read_b64_tr_b16 %6, %9 offset:2048\n\t"
                 "ds_read_b64_tr_b16 %7, %9 offset:3072\n\t"
                 "s_waitcnt lgkmcnt(0)"
                 : "=&v"(t0), "=&v"(t1), "=&v"(t2), "=&v"(t3), "=&v"(t4), "=&v"(t5), "=&v"(t6), "=&v"(t7) : "v"(ta0), "v"(ta1) : "memory");
    const bf16x8 v00 = __builtin_shufflevector(t0, t1, 0, 1, 2, 3, 4, 5, 6, 7), v01 = __builtin_shufflevector(t2, t3, 0, 1, 2, 3, 4, 5, 6, 7);
    const bf16x8 v10 = __builtin_shufflevector(t4, t5, 0, 1, 2, 3, 4, 5, 6, 7), v11 = __builtin_shufflevector(t6, t7, 0, 1, 2, 3, 4, 5, 6, 7);
    o0 = __builtin_amdgcn_mfma_f32_32x32x16_bf16(v00, pf0, o0, 0, 0, 0);
    o0 = __builtin_amdgcn_mfma_f32_32x32x16_bf16(v01, pf1, o0, 0, 0, 0);
    o1 = __builtin_amdgcn_mfma_f32_32x32x16_bf16(v10, pf0, o1, 0, 0, 0);
    o1 = __builtin_amdgcn_mfma_f32_32x32x16_bf16(v11, pf1, o1, 0, 0, 0);
}
#define ATT_STEP(TIX_, KCUR_, KNXT_) { const int tix_ = (TIX_); \
    const int d_ = tix_ < 5 ? 16 : tix_ < 10 ? 4 : 1, tau_ = tix_ < 5 ? tix_ : tix_ < 10 ? tix_ - 5 : tix_ - 10; \
    const int D0_ = dq + d_ * (32 * tau_ + 4 * h); const int lim_ = (128 * d_) < tq ? (128 * d_) : tq; \
    const bool msk_ = (d_ == 1) || tau_ == 0 || tau_ == 4 || (utop - d_ * (32 * tau_ + 31) < 0); \
    f32x16 sa_; attn_tile_a(msk_, d_, KCUR_, qf, sa_, mrow, D0_, lim_, nsl); \
    attn_issue_k(kbase, utop, tix_ + 2, n, KNXT_); attn_issue_v(vbase, utop, tix_ + 3, lane, vring); \
    attn_tile_b(tix_ == 0, sa_, o0, o1, mrow, lrow, ta0 + (unsigned)((tix_ & 3) * 4096), ta1 + (unsigned)((tix_ & 3) * 4096)); }
DI void attn_phase(const Params& p, LAS unsigned char* lds) {
    const int tid = threadIdx.x, wid = __builtin_amdgcn_readfirstlane(tid >> 6), lane = tid & 63, n = lane & 31, h = lane >> 5, g = n >> 3, iq = n & 7;
    LAS unsigned char* vring = lds + wid * 16384;
    const unsigned vb = (unsigned)(uintptr_t)vring;
    unsigned ta0, ta1;
    { const int i16 = lane & 15, q = i16 >> 2, pp = i16 & 3, blk = (lane >> 4) & 1, sw = (q >> 1) & 1;
      const unsigned rowoff = (unsigned)(4 * h + q) * 128u + 8u * (pp & 1);
      ta0 = vb + rowoff + (unsigned)(((2 * blk + (pp >> 1)) ^ (sw << 2)) * 16);
      ta1 = vb + rowoff + (unsigned)(((4 + 2 * blk + (pp >> 1)) ^ (sw << 2)) * 16); }
    for (int gidx = blockIdx.x; gidx < 1024; gidx += gridDim.x) {
        const int xx = gidx & 7, cj = (gidx >> 3) & 31, it = gidx >> 8, pair = xx + 8 * it, b = pair >> 2, kvh = pair & 3, T0 = cj * 128;
        const bf16_t* projb = p.PROJ + (size_t)b * SEQ * INC;
        const char* kbase = (const char*)(projb + COL_K + kvh * 64 + 8 * h);
        const char* vbase = (const char*)(projb + COL_V + kvh * 64 + 8 * ((lane & 7) ^ (((lane >> 4) & 1) << 2)));
        for (int rr = 0; rr < 2; ++rr) {
            const int r = wid + 8 * rr, tq = T0 + r + 16 * iq, utop = T0 + r + 112, head = kvh * 4 + g, dq = -16 * (7 - iq);
            const float nsl = -fexp2(-0.5f * (float)(head + 1)) * LOG2E;
            bf16x8 qf[4];
            { const bf16_t* qp = projb + (size_t)tq * INC + head * 64 + 8 * h;
#pragma unroll
              for (int s = 0; s < 4; ++s) qf[s] = *(const bf16x8*)(qp + 16 * s); }
            f32x16 o0, o1;
#pragma unroll
            for (int i = 0; i < 16; ++i) { o0[i] = 0.f; o1[i] = 0.f; }
            float mrow = 0.f, lrow = 0.f;
            bf16x8 kA[4], kB[4], kC[4];
            asm volatile("s_waitcnt vmcnt(0)" ::: "memory");
            attn_issue_v(vbase, utop, 0, lane, vring); attn_issue_v(vbase, utop, 1, lane, vring); attn_issue_v(vbase, utop, 2, lane, vring);
            attn_issue_k(kbase, utop, 0, n, kA); attn_issue_k(kbase, utop, 1, n, kB);
            asm volatile("" ::: "memory");
            for (int tix = 0; tix < 18; tix += 3) { ATT_STEP(tix, kA, kC) ATT_STEP(tix + 1, kB, kA) ATT_STEP(tix + 2, kC, kB) }
            const float inv = 1.0f / lrow;
            const bf16_t* gp = projb + (size_t)tq * INC + COL_AG + head * 64 + 4 * h;
            bf16_t* yp = p.Y + ((size_t)b * SEQ + tq) * MIXW + head * 64 + 4 * h;
#pragma unroll
            for (int ct = 0; ct < 2; ++ct)
#pragma unroll
                for (int gq = 0; gq < 4; ++gq) { const u32x2 gw = *(const u32x2*)(gp + 32 * ct + 8 * gq);
                    const float a0 = (ct ? o1[4 * gq] : o0[4 * gq]) * inv * bf_lo(gw.x), a1 = (ct ? o1[4 * gq + 1] : o0[4 * gq + 1]) * inv * bf_hi(gw.x);
                    const float a2 = (ct ? o1[4 * gq + 2] : o0[4 * gq + 2]) * inv * bf_lo(gw.y), a3 = (ct ? o1[4 * gq + 3] : o0[4 * gq + 3]) * inv * bf_hi(gw.y);
                    u32x2 ow; ow.x = pk_bf16(a0, a1); ow.y = pk_bf16(a2, a3);
                    *(u32x2*)(yp + 32 * ct + 8 * gq) = ow; }
            asm volatile("s_waitcnt vmcnt(0)" ::: "memory");
        }
    }
}

#define CONV_BFLY(V, N, MASK) { _Pragma("unroll") for (int i_ = 0; i_ < (N); ++i_) { const bool up_ = (lane & (MASK)) != 0; const float keep_ = up_ ? V[i_ + (N)] : V[i_]; const float send_ = up_ ? V[i_] : V[i_ + (N)]; V[i_] = keep_ + __shfl_xor(send_, (MASK)); } }
DI void conv_phase(const Params& p, LAS unsigned char* lds) {
    const int tid = threadIdx.x, wid = tid >> 6, lane = tid & 63, ch = tid * 2;
    f32x2v w[31];
#pragma unroll
    for (int k = 0; k < 31; ++k) w[k] = *(const f32x2v*)(p.conv_w + k * DM + ch);
    const f32x2v cb = *(const f32x2v*)(p.conv_b + ch), lg = *(const f32x2v*)(p.ln_g + ch), lb = *(const f32x2v*)(p.ln_b + ch);
    LAS float* part = (LAS float*)lds;
    LAS float* stats = part + 512;
    for (int tile_ = blockIdx.x; tile_ < (NTOK / 32) * p.rep_conv; tile_ += gridDim.x) {
        const int tile = tile_ & (NTOK / 32 - 1);
        const int tok0 = tile * 32, b = tok0 / SEQ, s0 = tok0 % SEQ;
        const bf16_t* projb = p.PROJ + (size_t)b * SEQ * INC;
        f32x2v acc[32];
#pragma unroll
        for (int t = 0; t < 32; ++t) acc[t] = cb;
#pragma clang loop unroll(full)
        for (int js = 0; js < 62; ++js) {
            const int s = s0 - 30 + js;
            f32x2v xin = {0.f, 0.f};
            if (s >= 0) { const unsigned vv = *(const unsigned*)(projb + (size_t)s * INC + ch + COL_CV); xin[0] = bf_lo(vv); xin[1] = bf_hi(vv); }
#pragma clang loop unroll(full)
            for (int t = 0; t < 32; ++t) { const int k = js - t; if (k >= 0 && k <= 30) acc[t] += w[k] * xin; }
        }
        float v1[32], v2[32];
#pragma unroll
        for (int t = 0; t < 32; ++t) { v1[t] = acc[t][0] + acc[t][1]; v2[t] = acc[t][0] * acc[t][0] + acc[t][1] * acc[t][1]; }
        CONV_BFLY(v1, 16, 32) CONV_BFLY(v1, 8, 16) CONV_BFLY(v1, 4, 8) CONV_BFLY(v1, 2, 4) CONV_BFLY(v1, 1, 2)
        CONV_BFLY(v2, 16, 32) CONV_BFLY(v2, 8, 16) CONV_BFLY(v2, 4, 8) CONV_BFLY(v2, 2, 4) CONV_BFLY(v2, 1, 2)
        v1[0] += __shfl_xor(v1[0], 1); v2[0] += __shfl_xor(v2[0], 1);
        if ((lane & 1) == 0) { part[(wid * 32 + (lane >> 1)) * 2] = v1[0]; part[(wid * 32 + (lane >> 1)) * 2 + 1] = v2[0]; }
        __syncthreads();
        if (tid < 32) { float a = 0.f, q = 0.f;
#pragma unroll
            for (int wv = 0; wv < 8; ++wv) { a += part[(wv * 32 + tid) * 2]; q += part[(wv * 32 + tid) * 2 + 1]; }
            const float mean = a * (1.0f / DM), var = q * (1.0f / DM) - mean * mean;
            stats[tid * 2] = mean; stats[tid * 2 + 1] = rsqrtf(fmaxf(var, 0.f) + 1e-5f); }
        __syncthreads();
#pragma unroll
        for (int t = 0; t < 32; ++t) { const float mean = stats[t * 2], rstd = stats[t * 2 + 1];
            const unsigned gw = *(const unsigned*)(projb + (size_t)(s0 + t) * INC + COL_CGATE + ch);
            const float y0 = silu((acc[t][0] - mean) * rstd * lg[0] + lb[0]) * bf_lo(gw), y1 = silu((acc[t][1] - mean) * rstd * lg[1] + lb[1]) * bf_hi(gw);
            *(unsigned*)(p.Y + ((size_t)tok0 + t) * MIXW + DM + ch) = pk_bf16(y0, y1); }
    }
}

DI void final_phase(const Params& p) {
    const int tid = threadIdx.x, wid = tid >> 6, lane = tid & 63;
    f32x4 g[2][2];
#pragma unroll
    for (int j = 0; j < 2; ++j) { g[j][0] = *(const f32x4*)(p.fin_g + j * 512 + lane * 8); g[j][1] = *(const f32x4*)(p.fin_g + j * 512 + lane * 8 + 4); }
    for (int row0 = (blockIdx.x * 8 + wid) * 4; row0 < NTOK; row0 += gridDim.x * 32) {
        float part = p.rowss[(size_t)row0 * 16 + lane];
        f32x4 v[4][2][2];
#pragma unroll
        for (int r = 0; r < 4; ++r)
#pragma unroll
            for (int j = 0; j < 2; ++j) { const float* orow = p.out + (size_t)(row0 + r) * DM + j * 512 + lane * 8; v[r][j][0] = *(const f32x4*)orow; v[r][j][1] = *(const f32x4*)(orow + 4); }
        part += __shfl_xor(part, 1); part += __shfl_xor(part, 2); part += __shfl_xor(part, 4); part += __shfl_xor(part, 8);
#pragma unroll
        for (int r = 0; r < 4; ++r) { const float tot = __shfl(part, r * 16); const float rstd = rsqrtf(tot * (1.0f / DM) + 1e-6f);
#pragma unroll
            for (int j = 0; j < 2; ++j) { float* orow = p.out + (size_t)(row0 + r) * DM + j * 512 + lane * 8; *(f32x4*)orow = v[r][j][0] * rstd * g[j][0]; *(f32x4*)(orow + 4) = v[r][j][1] * rstd * g[j][1]; } }
    }
}

template <int PH> __global__ void __launch_bounds__(512, 2) fwd_kernel(Params p) {
    extern __shared__ __attribute__((aligned(16))) unsigned char shm[];
    LAS unsigned char* lds = (LAS unsigned char*)shm;
    __shared__ uint4 xb_words;
    XcdBarrier xb;
    if constexpr (PH == 31) { if (threadIdx.x == 0) xb_words = make_uint4(0u, 0u, 0u, 0u); __syncthreads(); xb = xcd_barrier_post(p.bar, (volatile LAS unsigned*)&xb_words); }
    if constexpr (PH & 1) prep_phase(p, lds);
    if constexpr ((PH & 1) && (PH & 2)) cg::this_grid().sync();
    if constexpr (PH & 2) { pg8::Gemm g{p.H, p.WinT, NTOK, INC, DM}; pg8::StaticOrder S; S.init(NTOK, INC, (int)gridDim.x, (int)blockIdx.x); EpiProj E{p.PROJ};
        pg8::gemm_phase<EpiProj, pg8::StaticOrder, false>(lds, g, S, E, nullptr); }
    if constexpr ((PH & 2) && (PH & 4)) xcd_barrier(xb);
    if constexpr (PH & 4) {
#ifndef NO_ATTN
        attn_phase(p, lds); __syncthreads();
#endif
#ifndef NO_CONV
        conv_phase(p, lds);
#endif
    }
    if constexpr ((PH & 4) && (PH & 8)) xcd_barrier(xb);
    if constexpr (PH & 8) { __syncthreads(); pg8::Gemm g{p.Y, p.WoutT, NTOK, DM, MIXW}; pg8::StaticOrder S; S.init(NTOK, DM, (int)gridDim.x, (int)blockIdx.x); EpiOut E{p.x, p.out, p.rowss};
        pg8::gemm_phase<EpiOut, pg8::StaticOrder, false>(lds, g, S, E, nullptr); }
    if constexpr ((PH & 8) && (PH & 16)) xcd_barrier(xb);
    if constexpr (PH == 31) { for (int rep = 0; rep < p.rep_sync; ++rep) xcd_barrier(xb); }
    if constexpr (PH & 16) final_phase(p);
}

#ifndef N_LAUNCH_MODE
#define N_LAUNCH_MODE 1
#endif
extern "C" void kernel_launch(void* const* d_in, const int* in_sizes, int n_in, void* d_out, int out_size, void* d_ws, size_t ws_size, hipStream_t stream) {
    (void)in_sizes; (void)n_in; (void)out_size;
    Params p{};
    p.x = (const float*)d_in[0]; p.norm_g = (const float*)d_in[1]; p.w_in = (const float*)d_in[2]; p.conv_w = (const float*)d_in[3]; p.conv_b = (const float*)d_in[4];
    p.ln_g = (const float*)d_in[5]; p.ln_b = (const float*)d_in[6]; p.w_out = (const float*)d_in[7]; p.fin_g = (const float*)d_in[8];
    p.out = (float*)d_out;
    p.H = (bf16_t*)d_out;
    char* ws = (char*)d_ws; size_t off = 0;
    p.PROJ = (bf16_t*)(ws + off); off += (size_t)NTOK * INC * 2;
    p.Y = (bf16_t*)(ws + off); off += (size_t)NTOK * MIXW * 2;
    p.WinT = (bf16_t*)(ws + off); off += (size_t)INC * DM * 2;
    p.WoutT = (bf16_t*)(ws + off); off += (size_t)DM * MIXW * 2;
    p.rowss = (float*)(ws + off); off += (size_t)NTOK * 16 * 4;
    p.bar = (unsigned*)(ws + off); off += (size_t)XCD_BAR_WORDS * 4;
#ifdef REP_CONV
    p.rep_conv = REP_CONV;
#else
    p.rep_conv = 1;
#endif
#ifdef REP_SYNC
    p.rep_sync = REP_SYNC;
#else
    p.rep_sync = 0;
#endif
    if (off > ws_size) { fprintf(stderr, "kernel_launch: workspace too small (%zu needed, %zu given)\n", off, ws_size); return; }
    static int grid = 0;
    if (!grid) {
        int dev = 0, cus = 0, per_cu = 0; hipGetDevice(&dev); hipDeviceGetAttribute(&cus, hipDeviceAttributeMultiprocessorCount, dev);
        hipFuncSetAttribute((const void*)fwd_kernel<31>, hipFuncAttributeMaxDynamicSharedMemorySize, LDS_BYTES);
        hipFuncSetAttribute((const void*)fwd_kernel<1>, hipFuncAttributeMaxDynamicSharedMemorySize, LDS_BYTES);
        hipFuncSetAttribute((const void*)fwd_kernel<2>, hipFuncAttributeMaxDynamicSharedMemorySize, LDS_BYTES);
        hipFuncSetAttribute((const void*)fwd_kernel<4>, hipFuncAttributeMaxDynamicSharedMemorySize, LDS_BYTES);
        hipFuncSetAttribute((const void*)fwd_kernel<8>, hipFuncAttributeMaxDynamicSharedMemorySize, LDS_BYTES);
        hipFuncSetAttribute((const void*)fwd_kernel<16>, hipFuncAttributeMaxDynamicSharedMemorySize, LDS_BYTES);
        hipOccupancyMaxActiveBlocksPerMultiprocessor(&per_cu, (const void*)fwd_kernel<31>, 512, LDS_BYTES);
        if (per_cu < 1) { fprintf(stderr, "kernel_launch: occupancy query says 0 blocks/CU\n"); per_cu = 1; }
        grid = cus * per_cu;
    }
#if N_LAUNCH_MODE == 1
    hipMemsetAsync(p.bar, 0, (size_t)XCD_BAR_WORDS * 4, stream);
    void* args[] = {&p};
    hipError_t e = hipLaunchCooperativeKernel((const void*)fwd_kernel<31>, dim3(grid), dim3(512), args, LDS_BYTES, stream);
    if (e != hipSuccess) fprintf(stderr, "cooperative launch failed: %s (grid %d)\n", hipGetErrorString(e), grid);
#else
    hipLaunchKernelGGL(fwd_kernel<1>, dim3(grid), dim3(512), LDS_BYTES, stream, p);
    hipLaunchKernelGGL(fwd_kernel<2>, dim3(grid), dim3(512), LDS_BYTES, stream, p);
    hipLaunchKernelGGL(fwd_kernel<4>, dim3(grid), dim3(512), LDS_BYTES, stream, p);
    hipLaunchKernelGGL(fwd_kernel<8>, dim3(grid), dim3(512), LDS_BYTES, stream, p);
    hipLaunchKernelGGL(fwd_kernel<16>, dim3(grid), dim3(512), LDS_BYTES, stream, p);
#endif
}
```
